# Optimizing an MI355X kernel written in HIP

```python
import math
import jax, jax.numpy as jnp
from jax import lax
import numpy as np

D_MODEL = 1024
BATCH = 4
SEQ = 8192
DEPTH = 2

HEAD_DIM = 64
NSA_HEADS = 4
NSA_W = NSA_HEADS * HEAD_DIM
NSA_CMP_LEN = 32
NSA_CMP_STRIDE = 16
NSA_CMP_HIDDEN = 256
NSA_SEL_BLOCK = 64
NSA_TOPN = 16
NSA_WINDOW = 512
MOBA_HEADS = 4
MOBA_W = MOBA_HEADS * HEAD_DIM
MOBA_BLOCK = 256
MOBA_TOPK = 3
CONV_CH = 256
CONV_WIDTH = 31
HGRN_HEADS = 4
HGRN_KDIM = 64
HGRN_VDIM = 64
HGRN_W = HGRN_HEADS * HGRN_VDIM
HGRN_CHUNK = 64
MIX_WIDTH = NSA_W + MOBA_W + CONV_CH + HGRN_W
IN_WIDTHS = (NSA_W, HEAD_DIM, HEAD_DIM, HEAD_DIM, HEAD_DIM, HEAD_DIM, HEAD_DIM, 3 * NSA_HEADS,
             MOBA_W, MOBA_W, MOBA_W, 2 * CONV_CH, HGRN_W, HGRN_W, HGRN_W, HGRN_W)
IN_COLS = NSA_W + 6 * HEAD_DIM + 3 * NSA_HEADS + 3 * MOBA_W + 2 * CONV_CH + 4 * HGRN_W
D_FF = 4 * D_MODEL
REL_BUCKETS = 32
REL_MAX_EXACT = 16
REL_MAX_DIST = 128
N_ATTN_HEADS = NSA_HEADS + MOBA_HEADS
Q_BLOCK = 128
LN_EPS = 1e-5
RMS_EPS = 1e-6
BIG = 1e9
DEEPNORM_ALPHA = (2 * DEPTH) ** 0.25
DEEPNORM_BETA = (8 * DEPTH) ** -0.25

kernel_name = 'hymba_style_nsa_moba_conv_hgrn2_block'


def layer_norm(x, g, b):
    xf = x.astype(jnp.float32)
    mu = jnp.mean(xf, -1, keepdims=True)
    var = jnp.mean(jnp.square(xf - mu), -1, keepdims=True)
    return ((xf - mu) * lax.rsqrt(var + LN_EPS)).astype(x.dtype) * g + b


def masked_softmax(s, mask):
    s = jnp.where(mask, s.astype(jnp.float32), -jnp.inf)
    m = jnp.max(s, -1, keepdims=True)
    m = jnp.where(jnp.isfinite(m), m, 0.0)
    p = jnp.where(mask, jnp.exp(s - m), 0.0)
    return p / jnp.maximum(jnp.sum(p, -1, keepdims=True), 1e-30)


def rel_bucket(dist):
    n = jnp.maximum(dist, 0)
    nf = jnp.maximum(n, 1).astype(jnp.float32)
    large = REL_MAX_EXACT + (jnp.log(nf / REL_MAX_EXACT) / math.log(REL_MAX_DIST / REL_MAX_EXACT)
                             * (REL_BUCKETS - REL_MAX_EXACT)).astype(jnp.int32)
    return jnp.where(n < REL_MAX_EXACT, n, jnp.minimum(large, REL_BUCKETS - 1))


def nsa_compress(k, pe, w1, b1, w2):
    B, S, dh = k.shape
    n_cmp = (S - NSA_CMP_LEN) // NSA_CMP_STRIDE + 1
    idx = jnp.arange(n_cmp)[:, None] * NSA_CMP_STRIDE + jnp.arange(NSA_CMP_LEN)[None, :]
    blocks = (k[:, idx] + pe).reshape(B, n_cmp, NSA_CMP_LEN * dh)
    return jax.nn.gelu(blocks @ w1 + b1) @ w2


def nsa_attention(q, kc, vc, ks, vs, kw, vw, gates, tab):
    B, S, H, dh = q.shape
    n_cmp = kc.shape[1]
    n_sel = S // NSA_SEL_BLOCK
    topn = min(NSA_TOPN, n_sel)
    scale = dh ** -0.5
    cmp_start = jnp.arange(n_cmp) * NSA_CMP_STRIDE
    cmp_end = cmp_start + NSA_CMP_LEN - 1
    sel_start = jnp.arange(n_sel) * NSA_SEL_BLOCK
    overlap = jnp.clip(jnp.minimum(cmp_end[:, None] + 1, sel_start[None, :] + NSA_SEL_BLOCK)
                       - jnp.maximum(cmp_start[:, None], sel_start[None, :]), 0, None).astype(jnp.float32) / NSA_CMP_LEN
    kw_pad = jnp.pad(kw, ((0, 0), (NSA_WINDOW, 0), (0, 0)))
    vw_pad = jnp.pad(vw, ((0, 0), (NSA_WINDOW, 0), (0, 0)))
    bi = jnp.arange(B)[:, None, None]
    jsel = jnp.arange(n_sel)

    def block(c):
        s0 = c * Q_BLOCK
        qb = lax.dynamic_slice_in_dim(q, s0, Q_BLOCK, axis=1) * scale
        gb = lax.dynamic_slice_in_dim(gates, s0, Q_BLOCK, axis=1)
        t = s0 + jnp.arange(Q_BLOCK)
        dist_c = t[:, None] - cmp_end[None, :]
        s_c = jnp.einsum('bthd,bnd->bhtn', qb, kc) + tab[:, rel_bucket(dist_c)][None]
        p_c = masked_softmax(s_c, dist_c >= 0)
        o_c = jnp.einsum('bhtn,bnd->bthd', p_c.astype(vc.dtype), vc)
        imp = jnp.einsum('bhtn,nj->btj', p_c, overlap)
        blk_t = t // NSA_SEL_BLOCK
        forced = (jsel[None, :] == 0) | (jsel[None, :] == blk_t[:, None]) | (jsel[None, :] == blk_t[:, None] - 1)
        valid = jsel[None, :] <= blk_t[:, None]
        imp = jnp.where(forced, BIG, jnp.where(valid, imp, -BIG))
        _, sel = lax.top_k(imp, topn)
        pos = (sel[..., None] * NSA_SEL_BLOCK + jnp.arange(NSA_SEL_BLOCK)).reshape(B, Q_BLOCK, topn * NSA_SEL_BLOCK)
        k_sel = ks[bi, pos]
        v_sel = vs[bi, pos]
        dist_s = t[None, :, None] - pos
        s_s = jnp.einsum('bthd,btkd->bhtk', qb, k_sel) + jnp.moveaxis(tab[:, rel_bucket(dist_s)], 0, 1)
        p_s = masked_softmax(s_s, (dist_s >= 0)[:, None])
        o_s = jnp.einsum('bhtk,btkd->bthd', p_s.astype(v_sel.dtype), v_sel)
        kwb = lax.dynamic_slice_in_dim(kw_pad, s0, Q_BLOCK + NSA_WINDOW, axis=1)
        vwb = lax.dynamic_slice_in_dim(vw_pad, s0, Q_BLOCK + NSA_WINDOW, axis=1)
        kpos = s0 - NSA_WINDOW + jnp.arange(Q_BLOCK + NSA_WINDOW)
        dist_w = t[:, None] - kpos[None, :]
        mask_w = (dist_w >= 0) & (dist_w < NSA_WINDOW) & (kpos[None, :] >= 0)
        s_w = jnp.einsum('bthd,bkd->bhtk', qb, kwb) + tab[:, rel_bucket(dist_w)][None]
        p_w = masked_softmax(s_w, mask_w)
        o_w = jnp.einsum('bhtk,bkd->bthd', p_w.astype(vwb.dtype), vwb)
        return gb[..., 0:1] * o_c + gb[..., 1:2] * o_s + gb[..., 2:3] * o_w

    out = lax.map(block, jnp.arange(S // Q_BLOCK))
    return jnp.moveaxis(out, 0, 1).reshape(B, S, H * dh)


def moba_attention(q, k, v, tab):
    B, S, H, dh = q.shape
    s_pad = -(-S // MOBA_BLOCK) * MOBA_BLOCK
    nb = s_pad // MOBA_BLOCK
    ktop = min(MOBA_TOPK, nb)
    scale = dh ** -0.5
    padw = ((0, 0), (0, s_pad - S), (0, 0), (0, 0))
    kbh = jnp.pad(k, padw).reshape(B, nb, MOBA_BLOCK, H, dh).transpose(0, 3, 1, 2, 4)
    vbh = jnp.pad(v, padw).reshape(B, nb, MOBA_BLOCK, H, dh).transpose(0, 3, 1, 2, 4)
    k_mean = jnp.mean(kbh, axis=3)
    bi = jnp.arange(B)[:, None, None, None]
    hi = jnp.arange(H)[None, :, None, None]
    jblk = jnp.arange(nb)

    def block(c):
        s0 = c * Q_BLOCK
        qb = lax.dynamic_slice_in_dim(q, s0, Q_BLOCK, axis=1) * scale
        t = s0 + jnp.arange(Q_BLOCK)
        own = s0 // MOBA_BLOCK
        gate = jnp.einsum('bthd,bhnd->bhtn', qb, k_mean).astype(jnp.float32)
        gate = jnp.where((jblk < own)[None, None, None, :], gate, -BIG)
        gv, sel = lax.top_k(gate, ktop)
        sel_ok = gv > -0.5 * BIG
        k_sel = kbh[bi, hi, sel].reshape(B, H, Q_BLOCK, ktop * MOBA_BLOCK, dh)
        v_sel = vbh[bi, hi, sel].reshape(B, H, Q_BLOCK, ktop * MOBA_BLOCK, dh)
        pos_sel = (sel[..., None] * MOBA_BLOCK + jnp.arange(MOBA_BLOCK)).reshape(B, H, Q_BLOCK, ktop * MOBA_BLOCK)
        bias_sel = tab[hi, rel_bucket(t[None, None, :, None] - pos_sel)]
        s_sel = jnp.einsum('bthd,bhtkd->bhtk', qb, k_sel) + bias_sel
        mask_sel = jnp.repeat(sel_ok, MOBA_BLOCK, axis=-1)
        k_own = lax.dynamic_slice_in_dim(kbh, own, 1, axis=2)[:, :, 0]
        v_own = lax.dynamic_slice_in_dim(vbh, own, 1, axis=2)[:, :, 0]
        pos_own = own * MOBA_BLOCK + jnp.arange(MOBA_BLOCK)
        dist_own = t[:, None] - pos_own[None, :]
        s_own = jnp.einsum('bthd,bhkd->bhtk', qb, k_own) + tab[:, rel_bucket(dist_own)][None]
        mask_own = jnp.broadcast_to(dist_own >= 0, (B, H, Q_BLOCK, MOBA_BLOCK))
        p = masked_softmax(jnp.concatenate([s_sel, s_own], -1), jnp.concatenate([mask_sel, mask_own], -1))
        p_sel = p[..., :ktop * MOBA_BLOCK].astype(v.dtype)
        p_own = p[..., ktop * MOBA_BLOCK:].astype(v.dtype)
        return jnp.einsum('bhtk,bhtkd->bthd', p_sel, v_sel) + jnp.einsum('bhtk,bhkd->bthd', p_own, v_own)

    out = lax.map(block, jnp.arange(S // Q_BLOCK))
    return jnp.moveaxis(out, 0, 1).reshape(B, S, H * dh)


def conformer_conv(u, w_dw, b_dw, ln_g, ln_b, w_pw):
    a, g = jnp.split(u, 2, axis=-1)
    h = a * jax.nn.sigmoid(g)
    h = lax.conv_general_dilated(h, w_dw[:, None, :], window_strides=(1,),
                                 padding=[(CONV_WIDTH - 1, 0)],
                                 dimension_numbers=('NWC', 'WIO', 'NWC'),
                                 feature_group_count=CONV_CH) + b_dw
    h = jax.nn.silu(layer_norm(h, ln_g, ln_b))
    return h @ w_pw


def hgrn2_mixer(q, f_logit, i, g, lb, norm_g):
    B, S, _ = q.shape
    H, dk, dv, C = HGRN_HEADS, HGRN_KDIM, HGRN_VDIM, HGRN_CHUNK
    nc = S // C
    f = lb + (1.0 - lb) * jax.nn.sigmoid(f_logit.astype(jnp.float32))
    log_f = jnp.log(f)
    k = 1.0 - f

    def chunks(a, d):
        return a.astype(jnp.float32).reshape(B, nc, C, H, d).transpose(1, 0, 3, 2, 4)

    causal = jnp.tril(jnp.ones((C, C), dtype=bool))[:, :, None]

    def step(state, inp):
        qc, kc, vc, gc = inp
        cum = jnp.cumsum(gc, axis=2)
        diff = cum[:, :, :, None, :] - cum[:, :, None, :, :]
        decay = jnp.where(causal, jnp.exp(jnp.where(causal, diff, 0.0)), 0.0)
        attn = jnp.einsum('bhtk,bhsk,bhtsk->bhts', qc, kc, decay)
        o = jnp.einsum('bhtk,bhkv->bhtv', qc * jnp.exp(cum), state) + jnp.einsum('bhts,bhsv->bhtv', attn, vc)
        last = cum[:, :, -1:, :]
        state = jnp.exp(last[:, :, 0, :])[..., None] * state + jnp.einsum('bhsk,bhsv->bhkv', kc * jnp.exp(last - cum), vc)
        return state, o

    s_init = jnp.zeros((B, H, dk, dv), jnp.float32)
    _, o = lax.scan(step, s_init, (chunks(q, dk), chunks(k, dk), chunks(i, dv), chunks(log_f, dk)))
    o = o.transpose(1, 0, 3, 2, 4).reshape(B, S, H, dv)
    o = o * lax.rsqrt(jnp.mean(o * o, -1, keepdims=True) + RMS_EPS)
    return o.reshape(B, S, H * dv).astype(q.dtype) * norm_g * jax.nn.sigmoid(g)


def hybrid_layer(x, w_in, cmp_pe, cmp_w1, cmp_b1, cmp_w2, dw_w, dw_b, cln_g, cln_b, pw_w,
                 lb, hn_g, w_out, ln1_g, ln1_b, w_ff1, w_ff2, ln2_g, ln2_b, rel_tab):
    B, S, _ = x.shape
    split_points = [int(v) for v in np.cumsum(IN_WIDTHS)[:-1]]
    h = x @ w_in
    (q_n, kc, vc, ks, vs, kw, vw, g_n, q_m, k_m, v_m, conv_in,
     q_h, f_h, i_h, g_h) = jnp.split(h, split_points, axis=-1)
    kc = nsa_compress(kc, cmp_pe[0], cmp_w1[0], cmp_b1[0], cmp_w2[0])
    vc = nsa_compress(vc, cmp_pe[1], cmp_w1[1], cmp_b1[1], cmp_w2[1])
    gates = jax.nn.sigmoid(g_n.reshape(B, S, NSA_HEADS, 3))
    o_nsa = nsa_attention(q_n.reshape(B, S, NSA_HEADS, HEAD_DIM), kc, vc, ks, vs, kw, vw, gates,
                          rel_tab[:NSA_HEADS])
    o_moba = moba_attention(q_m.reshape(B, S, MOBA_HEADS, HEAD_DIM), k_m.reshape(B, S, MOBA_HEADS, HEAD_DIM),
                            v_m.reshape(B, S, MOBA_HEADS, HEAD_DIM), rel_tab[NSA_HEADS:])
    o_conv = conformer_conv(conv_in, dw_w, dw_b, cln_g, cln_b, pw_w)
    o_hgrn = hgrn2_mixer(q_h, f_h, i_h, g_h, lb, hn_g)
    mixed = jnp.concatenate([o_nsa, o_moba, o_conv, o_hgrn], axis=-1) @ w_out
    x = layer_norm(DEEPNORM_ALPHA * x + mixed, ln1_g, ln1_b)
    ff = jnp.square(jax.nn.relu(x @ w_ff1)) @ w_ff2
    return layer_norm(DEEPNORM_ALPHA * x + ff, ln2_g, ln2_b)


def setup_inputs(seed: int = 0) -> dict:
    key = jax.random.key(seed)
    ks = jax.random.split(key, 24)

    def nrm(k, shape, scale):
        return jax.random.normal(k, shape, jnp.float32) * scale

    return {
        'x': nrm(ks[0], (BATCH, SEQ, D_MODEL), 1.0),
        'w_in': nrm(ks[1], (DEPTH, D_MODEL, IN_COLS), D_MODEL ** -0.5),
        'nsa_cmp_pe': nrm(ks[2], (DEPTH, 2, NSA_CMP_LEN, HEAD_DIM), 0.1),
        'nsa_cmp_w1': nrm(ks[3], (DEPTH, 2, NSA_CMP_LEN * HEAD_DIM, NSA_CMP_HIDDEN), (NSA_CMP_LEN * HEAD_DIM) ** -0.5),
        'nsa_cmp_b1': nrm(ks[4], (DEPTH, 2, NSA_CMP_HIDDEN), 0.02),
        'nsa_cmp_w2': nrm(ks[5], (DEPTH, 2, NSA_CMP_HIDDEN, HEAD_DIM), NSA_CMP_HIDDEN ** -0.5),
        'conv_dw_w': nrm(ks[6], (DEPTH, CONV_WIDTH, CONV_CH), CONV_WIDTH ** -0.5),
        'conv_dw_b': nrm(ks[7], (DEPTH, CONV_CH), 0.02),
        'conv_ln_g': 1.0 + nrm(ks[8], (DEPTH, CONV_CH), 0.02),
        'conv_ln_b': nrm(ks[9], (DEPTH, CONV_CH), 0.02),
        'conv_pw_w': nrm(ks[10], (DEPTH, CONV_CH, CONV_CH), CONV_CH ** -0.5),
        'hgrn_lb_logits': nrm(ks[11], (DEPTH, HGRN_HEADS * HGRN_KDIM), 0.5),
        'hgrn_norm_g': 1.0 + nrm(ks[12], (DEPTH, HGRN_W), 0.02),
        'w_out': nrm(ks[13], (DEPTH, MIX_WIDTH, D_MODEL), MIX_WIDTH ** -0.5 * DEEPNORM_BETA),
        'ln1_g': 1.0 + nrm(ks[14], (DEPTH, D_MODEL), 0.02),
        'ln1_b': nrm(ks[15], (DEPTH, D_MODEL), 0.02),
        'w_ff1': nrm(ks[16], (DEPTH, D_MODEL, D_FF), D_MODEL ** -0.5),
        'w_ff2': nrm(ks[17], (DEPTH, D_FF, D_MODEL), D_FF ** -0.5 * DEEPNORM_BETA),
        'ln2_g': 1.0 + nrm(ks[18], (DEPTH, D_MODEL), 0.02),
        'ln2_b': nrm(ks[19], (DEPTH, D_MODEL), 0.02),
        'rel_bias': nrm(ks[20], (N_ATTN_HEADS, REL_BUCKETS), 0.5),
    }


def reference(x, w_in, nsa_cmp_pe, nsa_cmp_w1, nsa_cmp_b1, nsa_cmp_w2, conv_dw_w, conv_dw_b,
              conv_ln_g, conv_ln_b, conv_pw_w, hgrn_lb_logits, hgrn_norm_g, w_out, ln1_g, ln1_b,
              w_ff1, w_ff2, ln2_g, ln2_b, rel_bias):
    lb_sm = jax.nn.softmax(hgrn_lb_logits.astype(jnp.float32), axis=0)
    lbs = (jnp.cumsum(lb_sm, axis=0) - lb_sm[0]).astype(x.dtype)
    for l in range(DEPTH):
        x = hybrid_layer(x, w_in[l], nsa_cmp_pe[l], nsa_cmp_w1[l], nsa_cmp_b1[l], nsa_cmp_w2[l],
                         conv_dw_w[l], conv_dw_b[l], conv_ln_g[l], conv_ln_b[l], conv_pw_w[l],
                         lbs[l], hgrn_norm_g[l], w_out[l], ln1_g[l], ln1_b[l], w_ff1[l], w_ff2[l],
                         ln2_g[l], ln2_b[l], rel_bias)
    return x
```

```cpp
#include <hip/hip_runtime.h>
#include <cstdio>
#include <cstdint>
#include <cmath>

constexpr int B_ = 4, S_ = 8192, DM = 1024, DEPTH = 2, MTOK = B_ * S_;
constexpr int INC = 2956, FF = 4096, NCMP = 511;
constexpr float ALPHA = 1.4142135623730951f;
constexpr float BIGF = 1e9f;
typedef unsigned short bf16_t;
typedef float f32x4_t __attribute__((ext_vector_type(4)));
#define GAS __attribute__((address_space(1)))
#define LAS __attribute__((address_space(3)))

struct LayB { typedef bf16_t T; static constexpr int P = 3072, QN = 0, KC = 256, VC = 320, KS = 384, VS = 448, KW = 512, VW = 576, GN = 640,
              QM = 704, KM = 960, VM = 1216, CV = 1472, QH = 1984, FH = 2240, IH = 2496, GH = 2752; };
constexpr int HP = LayB::P, SHIFT_AT = 652, SHIFT = 52;

__device__ const unsigned char BUCKET_LUT[128] = {0,1,2,3,4,5,6,7,8,9,10,11,12,13,14,15,16,16,16,17,17,18,18,18,19,19,19,20,20,20,20,21,21,21,21,22,22,22,22,22,23,23,23,23,23,23,24,24,24,24,24,24,25,25,25,25,25,25,25,26,26,26,26,26,26,26,26,27,27,27,27,27,27,27,27,27,27,28,28,28,28,28,28,28,28,28,28,29,29,29,29,29,29,29,29,29,29,29,29,30,30,30,30,30,30,30,30,30,30,30,30,30,30,31,31,31,31,31,31,31,31,31,31,31,31,31,31,31};
__device__ __forceinline__ int rel_bucket(int dist) { return dist >= 128 ? 31 : (int)BUCKET_LUT[dist < 0 ? 0 : dist]; }
__device__ __forceinline__ float sigmoidf_(float x) { return 1.0f / (1.0f + expf(-x)); }
__device__ __forceinline__ float bf2f(bf16_t v) { return __uint_as_float((unsigned)v << 16); }
__device__ __forceinline__ unsigned f2bf(float f) { unsigned u = __float_as_uint(f); return (u + 0x7fffu + ((u >> 16) & 1u)) >> 16; }
__device__ __forceinline__ unsigned pk2(float lo, float hi) { return f2bf(lo) | (f2bf(hi) << 16); }
__device__ __forceinline__ float ldf(const float* p) { return *p; }
__device__ __forceinline__ float ldf(const bf16_t* p) { return bf2f(*p); }

namespace pg8 {
#define PG8_LAS __attribute__((address_space(3)))
typedef unsigned short bf16_t;
typedef short bf16x8 __attribute__((ext_vector_type(8)));
typedef float f32x4 __attribute__((ext_vector_type(4)));
typedef unsigned u32x4 __attribute__((ext_vector_type(4)));
constexpr int BM = 256, BK = 64, HALF = 128, HTB = HALF * BK * 2  , STAGE_BYTES = 8 * HTB, NXCD = 8, WGM = 8;

__host__ __device__ __forceinline__ int lds_byte(int r, int c) { const int st = (r >> 4) * 2 + (c >> 5), rr = r & 15, cc = c & 31, ob = rr * 64 + cc * 2; return st * 1024 + (ob ^ (((ob >> 9) & 1) << 5)); }
__host__ __device__ __forceinline__ void stage_rc(int b, int& R, int& C) { const int st = b / 1024, sb = b % 1024, swz = sb ^ (((sb >> 9) & 1) << 5); R = (st >> 1) * 16 + swz / 64; C = (st & 1) * 32 + (swz % 64) / 2; }
__host__ __device__ __forceinline__ int perm32(int rho) { const int n = rho >> 4, i = rho & 15; return 8 * (i >> 2) + 4 * n + (i & 3); }

struct Unit { int pm, pn; };
struct Gemm { const bf16_t* A; const bf16_t* Bt; int M, N, K; };

struct StaticOrder {
    int nM, nN, nwg, G, c;
    __host__ __device__ void init(int M, int N, int G_, int c_) { nM = M / BM; nN = N / BM; nwg = nM * nN; G = G_; c = c_; }
    __host__ __device__ bool next(int i, Unit& u) const {
        const long L = (long)i * G + c; if (L >= nwg) return false;
        int wgid = (int)L; { const int q = nwg / NXCD, r = nwg % NXCD, xcd = wgid % NXCD, off = wgid / NXCD; wgid = (xcd < r ? xcd * (q + 1) : r * (q + 1) + (xcd - r) * q) + off; }
        const int nig = WGM * nN, gid = wgid / nig, fm = gid * WGM, gsz = (nM - fm) < WGM ? (nM - fm) : WGM;
        u.pm = fm + ((wgid % nig) % gsz); u.pn = (wgid % nig) / gsz; return true;
    }
    __device__ __forceinline__ void a_ready(const Unit&) const {}
    __device__ __forceinline__ void done(const Unit&) const {}
};


__device__ __forceinline__ unsigned cvt_pk_bf16(float lo, float hi) { unsigned r; asm volatile("v_cvt_pk_bf16_f32 %0, %1, %2" : "=v"(r) : "v"(lo), "v"(hi)); return r; }
template <int ACT  > struct EpiBf16 {
    static constexpr bool PERM = true, AFTER_DRAIN = false;
    bf16_t* O; int ldc;
    __device__ __forceinline__ void operator()(const f32x4 (&acc)[2][2][4][2], const Unit& u, int wr, int wc, int fr, int fq) const {
        const int row0 = u.pm * BM + wr * 64 + fr; const int col0 = u.pn * BM + wc * 32 + 8 * fq;
#pragma unroll
        for (int ai = 0; ai < 2; ++ai)
#pragma unroll
            for (int m = 0; m < 4; ++m) { bf16_t* rowp = O + (size_t)(row0 + ai * HALF + m * 16) * ldc + col0;
#pragma unroll
                for (int bj = 0; bj < 2; ++bj) { f32x4 v0 = acc[ai][bj][m][0], v1 = acc[ai][bj][m][1];
                    if (ACT == 2) {
#pragma unroll
                        for (int e = 0; e < 4; ++e) { const float a = v0[e] > 0.f ? v0[e] : 0.f, b = v1[e] > 0.f ? v1[e] : 0.f; v0[e] = a * a; v1[e] = b * b; } }
                    u32x4 w; w.x = cvt_pk_bf16(v0[0], v0[1]); w.y = cvt_pk_bf16(v0[2], v0[3]); w.z = cvt_pk_bf16(v1[0], v1[1]); w.w = cvt_pk_bf16(v1[2], v1[3]);
                    *(u32x4*)(rowp + bj * HALF) = w; } }
    }
};
struct EpiResF32 {
    static constexpr bool PERM = false, AFTER_DRAIN = false;
    const float* base; float* out; int ldc; float alpha;
    __device__ __forceinline__ void operator()(const f32x4 (&acc)[2][2][4][2], const Unit& u, int wr, int wc, int fr, int fq) const {
        const int col0 = u.pn * BM + wc * 32 + 4 * fq;
#pragma unroll
        for (int ai = 0; ai < 2; ++ai)
#pragma unroll
            for (int m = 0; m < 4; ++m) { const int r = ai * HALF + wr * 64 + m * 16 + fr; const size_t off = (size_t)(u.pm * BM + r) * ldc + col0;
#pragma unroll
                for (int bj = 0; bj < 2; ++bj)
#pragma unroll
                    for (int n = 0; n < 2; ++n) { const f32x4 bs = *(const f32x4*)(base + off + bj * HALF + n * 16); *(f32x4*)(out + off + bj * HALF + n * 16) = bs * alpha + acc[ai][bj][m][n]; }
                if (m & 1) asm volatile("" ::: "memory"); }
    }
};

template <class Epi, class Sched, bool ALIGN_EPI = false, bool SP2 = false>
__device__ __forceinline__ void gemm_phase(PG8_LAS unsigned char* lds, const Gemm g, const Sched& S, const Epi& E) {
    int tid_ = threadIdx.x; asm volatile("" : "+v"(tid_)); const int tid = tid_, wid = __builtin_amdgcn_readfirstlane(tid >> 6), lane = tid & 63, wr = wid >> 2, wc = wid & 3, fr = lane & 15, fq = lane >> 4;
    const int K = g.K, nt = K / BK;
    unsigned voffA[2], voffB[2];
#pragma unroll
    for (int i = 0; i < 2; ++i) { int R, C; stage_rc(tid * 16 + i * 8192, R, C); const int Rb = Epi::PERM ? ((R & ~31) + perm32(R & 31)) : R;
        voffA[i] = (unsigned)(R * K + C) * 2u; voffB[i] = (unsigned)(Rb * K + C) * 2u; }
    const size_t kstep = (size_t)(BK * 2);
    const size_t hstep = (size_t)HALF * K * 2;
    const size_t tstep = 2 * hstep;
    const unsigned ldsw = (unsigned)wid * 1024u;
    const int aoff = lds_byte(wr * 64 + fr, fq * 8), boff = lds_byte(wc * 32 + fr, fq * 8);
#define PG8_SA(b, h) (((b) * 2 + (h)) * HTB)
#define PG8_SB(b, h) ((4 + (b) * 2 + (h)) * HTB)
#define PG8_STAGE(bufoff, gbase, voff) do { _Pragma("unroll") for (int _i = 0; _i < 2; ++_i) \
        __builtin_amdgcn_global_load_lds((const unsigned*)((const char*)(gbase) + (voff)[_i]), (PG8_LAS unsigned*)(lds + (bufoff) + ldsw + _i * 8192), 16, 0, 0); } while (0)
#define PG8_LDA(dst, b, h) do { _Pragma("unroll") for (int m = 0; m < 4; ++m) _Pragma("unroll") for (int k = 0; k < 2; ++k) dst[m][k] = *(const PG8_LAS bf16x8*)(lds + PG8_SA(b, h) + aoff + m * 2048 + k * 1024); } while (0)
#define PG8_LDB(dst, b, h) do { _Pragma("unroll") for (int n = 0; n < 2; ++n) _Pragma("unroll") for (int k = 0; k < 2; ++k) dst[n][k] = *(const PG8_LAS bf16x8*)(lds + PG8_SB(b, h) + boff + n * 2048 + k * 1024); } while (0)
#define PG8_MMA(ai, bj, At, Bt) do { __builtin_amdgcn_s_setprio(1); _Pragma("unroll") for (int m = 0; m < 4; ++m) _Pragma("unroll") for (int n = 0; n < 2; ++n) _Pragma("unroll") for (int k = 0; k < 2; ++k) \
        acc[ai][bj][m][n] = __builtin_amdgcn_mfma_f32_16x16x32_bf16(Bt[n][k], At[m][k], acc[ai][bj][m][n], 0, 0, 0); __builtin_amdgcn_s_setprio(0); } while (0)
#define PG8_WAIT_V(n) asm volatile("s_waitcnt vmcnt(" #n ")" ::: "memory")
#define PG8_WAIT_L(n) asm volatile("s_waitcnt lgkmcnt(" #n ")" ::: "memory")
#define PG8_BAR __builtin_amdgcn_s_barrier()
#define PG8_SCHED __builtin_amdgcn_sched_barrier(0)
    Unit cur, nxt; int ui = 0;
    if (!S.next(0, cur)) return;
    f32x4 acc[2][2][4][2];
#pragma unroll
    for (int a = 0; a < 2; ++a)
#pragma unroll
        for (int b = 0; b < 2; ++b)
#pragma unroll
            for (int m = 0; m < 4; ++m)
#pragma unroll
                for (int n = 0; n < 2; ++n) acc[a][b][m][n] = (f32x4){0.f, 0.f, 0.f, 0.f};
    bf16x8 At[4][2], B0[2][2], B1[2][2];
    const char* cA = (const char*)g.A + (size_t)cur.pm * tstep; const char* cB = (const char*)g.Bt + (size_t)cur.pn * tstep;
    S.a_ready(cur);
    if constexpr (SP2) {
        PG8_STAGE(PG8_SB(0, 0), cB, voffB); PG8_STAGE(PG8_SB(0, 1), cB + hstep, voffB); PG8_STAGE(PG8_SA(0, 0), cA, voffA); PG8_STAGE(PG8_SA(0, 1), cA + hstep, voffA);
        if (wr == 1) PG8_BAR;
        PG8_WAIT_V(2); PG8_BAR;
        PG8_STAGE(PG8_SB(1, 0), cB + kstep, voffB); PG8_STAGE(PG8_SA(1, 0), cA + kstep, voffA); PG8_STAGE(PG8_SB(1, 1), cB + hstep + kstep, voffB);
        PG8_WAIT_V(6); PG8_BAR;
    } else {
        PG8_STAGE(PG8_SB(0, 0), cB, voffB); PG8_STAGE(PG8_SA(0, 0), cA, voffA); PG8_STAGE(PG8_SB(0, 1), cB + hstep, voffB); PG8_STAGE(PG8_SA(0, 1), cA + hstep, voffA);
        if (wr == 1) PG8_BAR;
        PG8_WAIT_V(4); PG8_BAR;
        PG8_STAGE(PG8_SB(1, 0), cB + kstep, voffB); PG8_STAGE(PG8_SA(1, 0), cA + kstep, voffA); PG8_STAGE(PG8_SB(1, 1), cB + hstep + kstep, voffB);
        PG8_WAIT_V(6); PG8_BAR;
    }
    for (;;) {
        const bool has_next = S.next(ui + 1, nxt);
        const char* nA = has_next ? (const char*)g.A + (size_t)nxt.pm * tstep : cA; const char* nB = has_next ? (const char*)g.Bt + (size_t)nxt.pn * tstep : cB;
        for (int t = 0; t < nt; t += 2) {
            const bool last = (t == nt - 2);
            const char* a1 = cA + (size_t)(t + 1) * kstep;
            const char* a2 = last ? nA : cA + (size_t)(t + 2) * kstep; const char* b2 = last ? nB : cB + (size_t)(t + 2) * kstep;
            const char* a3 = a2 + kstep; const char* b3 = b2 + kstep;
            if (last && has_next) S.a_ready(nxt);
            if constexpr (SP2) {
            PG8_LDB(B0, 0, 0); PG8_LDB(B1, 0, 1); PG8_SCHED; PG8_LDA(At, 0, 0); PG8_STAGE(PG8_SA(1, 1), a1 + hstep, voffA);
            PG8_WAIT_V(8); PG8_WAIT_L(0); PG8_BAR; PG8_MMA(0, 0, At, B0); PG8_MMA(0, 1, At, B1); PG8_BAR; PG8_SCHED;
            PG8_LDA(At, 0, 1); PG8_STAGE(PG8_SB(0, 0), b2, voffB); PG8_STAGE(PG8_SB(0, 1), b2 + hstep, voffB); PG8_STAGE(PG8_SA(0, 0), a2, voffA);
            PG8_WAIT_V(8); PG8_WAIT_L(0); PG8_BAR; PG8_MMA(1, 0, At, B0); PG8_MMA(1, 1, At, B1); PG8_BAR; PG8_SCHED;
            PG8_LDB(B0, 1, 0); PG8_LDB(B1, 1, 1); PG8_SCHED; PG8_LDA(At, 1, 0); PG8_STAGE(PG8_SA(0, 1), a2 + hstep, voffA);
            PG8_WAIT_V(8); PG8_WAIT_L(0); PG8_BAR; PG8_MMA(0, 0, At, B0); PG8_MMA(0, 1, At, B1); PG8_BAR; PG8_SCHED;
            PG8_LDA(At, 1, 1); PG8_STAGE(PG8_SB(1, 0), b3, voffB); PG8_STAGE(PG8_SB(1, 1), b3 + hstep, voffB); PG8_STAGE(PG8_SA(1, 0), a3, voffA);
            PG8_WAIT_V(8); PG8_WAIT_L(0); PG8_BAR; PG8_MMA(1, 0, At, B0); PG8_MMA(1, 1, At, B1); PG8_BAR; PG8_SCHED;
            } else {
            PG8_LDB(B0, 0, 0); PG8_SCHED; PG8_LDA(At, 0, 0); PG8_STAGE(PG8_SA(1, 1), a1 + hstep, voffA);
            PG8_WAIT_L(8); PG8_BAR; PG8_WAIT_L(0); PG8_MMA(0, 0, At, B0); PG8_BAR; PG8_SCHED;
            PG8_LDB(B1, 0, 1); PG8_STAGE(PG8_SB(0, 0), b2, voffB);
            PG8_BAR; PG8_WAIT_L(0); PG8_MMA(0, 1, At, B1); PG8_BAR;
            PG8_LDA(At, 0, 1); PG8_STAGE(PG8_SA(0, 0), a2, voffA);
            PG8_BAR; PG8_WAIT_L(0); PG8_MMA(1, 0, At, B0); PG8_BAR; PG8_SCHED;
            PG8_STAGE(PG8_SB(0, 1), b2 + hstep, voffB);
            PG8_WAIT_V(6); PG8_BAR; PG8_MMA(1, 1, At, B1); PG8_BAR;
            PG8_LDB(B0, 1, 0); PG8_SCHED; PG8_LDA(At, 1, 0); PG8_STAGE(PG8_SA(0, 1), a2 + hstep, voffA);
            PG8_WAIT_L(8); PG8_BAR; PG8_WAIT_L(0); PG8_MMA(0, 0, At, B0); PG8_BAR; PG8_SCHED;
            PG8_LDB(B1, 1, 1); PG8_STAGE(PG8_SB(1, 0), b3, voffB);
            PG8_BAR; PG8_WAIT_L(0); PG8_MMA(0, 1, At, B1); PG8_BAR;
            PG8_LDA(At, 1, 1); PG8_STAGE(PG8_SA(1, 0), a3, voffA);
            PG8_BAR; PG8_WAIT_L(0); PG8_MMA(1, 0, At, B0); PG8_BAR; PG8_SCHED;
            PG8_STAGE(PG8_SB(1, 1), b3 + hstep, voffB);
            PG8_WAIT_V(6); PG8_BAR; PG8_MMA(1, 1, At, B1); PG8_BAR;
            }
        }
        if constexpr (ALIGN_EPI) { if (wr == 0) PG8_BAR; }
        if constexpr (!Epi::AFTER_DRAIN) { E(acc, cur, wr, wc, fr, fq); S.done(cur); }
        if (!has_next) break;
#pragma unroll
        for (int a = 0; a < 2; ++a)
#pragma unroll
            for (int b = 0; b < 2; ++b)
#pragma unroll
                for (int m = 0; m < 4; ++m)
#pragma unroll
                    for (int n = 0; n < 2; ++n) acc[a][b][m][n] = (f32x4){0.f, 0.f, 0.f, 0.f};
        cur = nxt; cA = nA; cB = nB; ++ui;
        if constexpr (ALIGN_EPI) { if (wr == 1) PG8_BAR; }
    }
    PG8_WAIT_V(0);
    if constexpr (!ALIGN_EPI) { if (wr == 0) PG8_BAR; }
    PG8_BAR;
    if constexpr (Epi::AFTER_DRAIN) { E.fused(acc, cur, wr, wc, fr, fq, lds, wid, lane); S.done(cur); }
#undef PG8_SA
#undef PG8_SB
#undef PG8_STAGE
#undef PG8_LDA
#undef PG8_LDB
#undef PG8_MMA
#undef PG8_WAIT_V
#undef PG8_WAIT_L
#undef PG8_BAR
#undef PG8_SCHED
}
}

#define XB_TMO      128
#define XB_XCNT(j)  (256  + 64 * (j))
#define XB_XSUB(j)  (1280 + 64 * (j))
#define XB_XGEN(j)  (2304 + 64 * (j))
#define XB_TOP      3328
#define XB_TOPGEN   3392
#define XCD_BAR_WORDS 3456
#define XB_SPIN_CAP (1u << 26)

__device__ __forceinline__ unsigned xb_ld(unsigned* p)              { return __hip_atomic_load(p, __ATOMIC_RELAXED, __HIP_MEMORY_SCOPE_AGENT); }
__device__ __forceinline__ unsigned xb_add(unsigned* p, unsigned v) { return __hip_atomic_fetch_add(p, v, __ATOMIC_RELAXED, __HIP_MEMORY_SCOPE_AGENT); }
__device__ __forceinline__ unsigned xb_xcc_id() { return (unsigned)__builtin_amdgcn_s_getreg((3 << 11) | 20) & 0xFu; }
#define XB_SPIN(cond, bar) do { unsigned _sp = 0; while (cond) { __builtin_amdgcn_s_sleep(1); \
    if ((++_sp & 255u) == 0u) { if (xb_ld(&(bar)[XB_TMO])) break; if (_sp > XB_SPIN_CAP) { atomicAdd(&(bar)[XB_TMO], 1u); break; } } } } while (0)

struct XcdBarrier {
    unsigned* bar; unsigned x;
    volatile LAS unsigned* st;
};

__device__ __forceinline__ XcdBarrier xcd_barrier_post(unsigned* bar, volatile LAS unsigned* st) {
    XcdBarrier b; b.bar = bar; b.x = xb_xcc_id(); b.st = st;
    if (threadIdx.x == 0) (void)xb_add(&bar[XB_XCNT(b.x)], 1u);
    return b;
}
__device__ __forceinline__ void xcd_barrier_complete(unsigned* bar, unsigned x, unsigned& nloc, unsigned& nx) {
    const unsigned G = gridDim.x * gridDim.y * gridDim.z;
    unsigned sum, cnt, mine, sp = 0u;
    for (;;) {
        sum = 0u; cnt = 0u; mine = 0u;
#pragma unroll
        for (unsigned j = 0; j < 16; ++j) { const unsigned c = xb_ld(&bar[XB_XCNT(j)]); sum += c; cnt += (c > 0u) ? 1u : 0u; mine = (j == x) ? c : mine; }
        if (sum == G) break;
        __builtin_amdgcn_s_sleep(1);
        if ((++sp & 255u) == 0u) { if (xb_ld(&bar[XB_TMO])) break; if (sp > XB_SPIN_CAP) { atomicAdd(&bar[XB_TMO], 1u); break; } }
    }
    nloc = mine > 0u ? mine : 1u; nx = cnt > 0u ? cnt : 1u;
}

__device__ __forceinline__ void xcd_barrier(const XcdBarrier& b) {
    asm volatile("s_waitcnt vmcnt(0)" ::: "memory");
    __syncthreads();
    if (threadIdx.x == 0) {
        unsigned* bar = b.bar;
        __builtin_amdgcn_s_waitcnt(0);
        unsigned nloc = b.st[0], nx = b.st[1];
        if (nloc == 0u) { xcd_barrier_complete(bar, b.x, nloc, nx); b.st[0] = nloc; b.st[1] = nx; }
        const unsigned old = xb_add(&bar[XB_XSUB(b.x)], 1u);
        const unsigned gen = old / nloc;
        if (old + 1u == (gen + 1u) * nloc) {
            __builtin_amdgcn_fence(__ATOMIC_RELEASE, "agent");
            asm volatile("s_waitcnt vmcnt(0)" ::: "memory");
            const unsigned og = xb_add(&bar[XB_TOP], 1u);
            const unsigned tg = og / nx;
            if (og + 1u == (tg + 1u) * nx) xb_add(&bar[XB_TOPGEN], 1u);
            else XB_SPIN(xb_ld(&bar[XB_TOPGEN]) == tg, bar);
            __builtin_amdgcn_fence(__ATOMIC_ACQUIRE, "agent");
            xb_add(&bar[XB_XGEN(b.x)], 1u);
            asm volatile("s_waitcnt vmcnt(0)" ::: "memory");
        } else {
            XB_SPIN(xb_ld(&bar[XB_XGEN(b.x)]) == gen, bar);
            __builtin_amdgcn_fence(__ATOMIC_ACQUIRE, "agent");
            asm volatile("s_waitcnt vmcnt(0)" ::: "memory");
        }
    }
    __syncthreads();
}


constexpr size_t MiB = 1u << 20;
constexpr size_t WS_CTL = 0, CTL_ZERO_BYTES = 1 * MiB;
constexpr size_t WS_WIN = 1 * MiB;
constexpr size_t WS_WOUT = WS_WIN + 12 * MiB;
constexpr size_t WS_W1 = WS_WOUT + 4 * MiB;
constexpr size_t WS_W2 = WS_W1 + 16 * MiB;
constexpr size_t WS_XB = WS_W2 + 16 * MiB;
constexpr size_t WS_H = WS_XB + 64 * MiB;
constexpr size_t WS_MIX = WS_H + 192 * MiB;
constexpr size_t WS_HFF = WS_H;
constexpr size_t WS_KCV = WS_H + 256 * MiB;
constexpr size_t WS_KM = WS_KCV + 2 * MiB;
constexpr size_t WS_OL = WS_KM + 1 * MiB;
constexpr size_t WS_QP = WS_OL + 32 * MiB;
constexpr size_t WS_U = WS_QP + 32 * MiB;
constexpr size_t WS_DG = WS_U + 4 * MiB;
constexpr size_t WS_LBS = WS_DG + 1 * MiB;
constexpr size_t WS_RES = WS_LBS + 1 * MiB;
constexpr size_t WS_END = WS_RES + 32 * MiB;
static_assert(WS_END <= 512 * MiB, "workspace map");
constexpr int CW_BAR = 4096;
constexpr int RING_BYTES = 131072, LDSCTL_OFF = RING_BYTES, MISC_OFF = LDSCTL_OFF + 320, LDS_BYTES = 147456;
constexpr int NWAVES = 8, NTHR = 512;
constexpr int HSEG = 512, NSEG = S_ / HSEG, HT = 16;

__device__ __forceinline__ int fresh_tid() { int t = threadIdx.x; asm volatile("" : "+v"(t)); return t; }
__device__ __forceinline__ float dot64(const float (&q)[64], const float* __restrict__ k) {
    float s0 = 0.f, s1 = 0.f, s2 = 0.f, s3 = 0.f;
#pragma unroll
    for (int d = 0; d < 64; d += 4) { const float4 kv = *(const float4*)(k + d); s0 = fmaf(q[d], kv.x, s0); s1 = fmaf(q[d + 1], kv.y, s1); s2 = fmaf(q[d + 2], kv.z, s2); s3 = fmaf(q[d + 3], kv.w, s3); }
    return (s0 + s1) + (s2 + s3);
}
__device__ __forceinline__ float dot64(const float (&q)[64], const bf16_t* __restrict__ k) {
    float s0 = 0.f, s1 = 0.f, s2 = 0.f, s3 = 0.f;
#pragma unroll
    for (int c = 0; c < 8; ++c) { const uint4 w = *(const uint4*)(k + 8 * c);
        s0 = fmaf(q[8 * c + 0], __uint_as_float(w.x << 16), s0); s1 = fmaf(q[8 * c + 1], __uint_as_float(w.x & 0xffff0000u), s1);
        s2 = fmaf(q[8 * c + 2], __uint_as_float(w.y << 16), s2); s3 = fmaf(q[8 * c + 3], __uint_as_float(w.y & 0xffff0000u), s3);
        s0 = fmaf(q[8 * c + 4], __uint_as_float(w.z << 16), s0); s1 = fmaf(q[8 * c + 5], __uint_as_float(w.z & 0xffff0000u), s1);
        s2 = fmaf(q[8 * c + 6], __uint_as_float(w.w << 16), s2); s3 = fmaf(q[8 * c + 7], __uint_as_float(w.w & 0xffff0000u), s3); }
    return (s0 + s1) + (s2 + s3);
}
__device__ __forceinline__ void axpy64(float p, const float* __restrict__ v, float (&o)[64]) {
#pragma unroll
    for (int d = 0; d < 64; d += 4) { const float4 vv = *(const float4*)(v + d); o[d] = fmaf(p, vv.x, o[d]); o[d + 1] = fmaf(p, vv.y, o[d + 1]); o[d + 2] = fmaf(p, vv.z, o[d + 2]); o[d + 3] = fmaf(p, vv.w, o[d + 3]); }
}
__device__ __forceinline__ void axpy64(float p, const bf16_t* __restrict__ v, float (&o)[64]) {
#pragma unroll
    for (int c = 0; c < 8; ++c) { const uint4 w = *(const uint4*)(v + 8 * c);
        o[8 * c + 0] = fmaf(p, __uint_as_float(w.x << 16), o[8 * c + 0]); o[8 * c + 1] = fmaf(p, __uint_as_float(w.x & 0xffff0000u), o[8 * c + 1]);
        o[8 * c + 2] = fmaf(p, __uint_as_float(w.y << 16), o[8 * c + 2]); o[8 * c + 3] = fmaf(p, __uint_as_float(w.y & 0xffff0000u), o[8 * c + 3]);
        o[8 * c + 4] = fmaf(p, __uint_as_float(w.z << 16), o[8 * c + 4]); o[8 * c + 5] = fmaf(p, __uint_as_float(w.z & 0xffff0000u), o[8 * c + 5]);
        o[8 * c + 6] = fmaf(p, __uint_as_float(w.w << 16), o[8 * c + 6]); o[8 * c + 7] = fmaf(p, __uint_as_float(w.w & 0xffff0000u), o[8 * c + 7]); }
}
template <typename TV>
__device__ __forceinline__ void osm_step(float s, const TV* __restrict__ v, float& m, float& l, float (&o)[64]) {
    if (s > m) { const float f = expf(m - s); l *= f;
#pragma unroll
        for (int d = 0; d < 64; ++d) o[d] *= f;
        m = s; }
    const float p = expf(s - m); l += p;
    axpy64(p, v, o);
}
__device__ __forceinline__ void load_q64(float (&q)[64], const float* p, float sc) {
#pragma unroll
    for (int d = 0; d < 64; ++d) q[d] = p[d] * sc;
}
__device__ __forceinline__ void load_q64(float (&q)[64], const bf16_t* p, float sc) {
#pragma unroll
    for (int c = 0; c < 8; ++c) { const uint4 w = *(const uint4*)(p + 8 * c);
        q[8 * c + 0] = __uint_as_float(w.x << 16) * sc; q[8 * c + 1] = __uint_as_float(w.x & 0xffff0000u) * sc; q[8 * c + 2] = __uint_as_float(w.y << 16) * sc; q[8 * c + 3] = __uint_as_float(w.y & 0xffff0000u) * sc;
        q[8 * c + 4] = __uint_as_float(w.z << 16) * sc; q[8 * c + 5] = __uint_as_float(w.z & 0xffff0000u) * sc; q[8 * c + 6] = __uint_as_float(w.w << 16) * sc; q[8 * c + 7] = __uint_as_float(w.w & 0xffff0000u) * sc; }
}
__device__ __forceinline__ void store_row64(bf16_t* p, const float (&o)[64], float sc) {
#pragma unroll
    for (int c = 0; c < 8; ++c) { uint4 w; w.x = pk2(o[8 * c] * sc, o[8 * c + 1] * sc); w.y = pk2(o[8 * c + 2] * sc, o[8 * c + 3] * sc); w.z = pk2(o[8 * c + 4] * sc, o[8 * c + 5] * sc); w.w = pk2(o[8 * c + 6] * sc, o[8 * c + 7] * sc); *(uint4*)(p + 8 * c) = w; }
}


__device__ __forceinline__ void load_qp(unsigned (&qp)[32], const bf16_t* p) {
#pragma unroll
    for (int c = 0; c < 8; ++c) { const uint4 w = *(const uint4*)(p + 8 * c); qp[4 * c] = w.x; qp[4 * c + 1] = w.y; qp[4 * c + 2] = w.z; qp[4 * c + 3] = w.w; }
}
#define QLO(u) __uint_as_float((u) << 16)
#define QHI(u) __uint_as_float((u) & 0xffff0000u)
__device__ __forceinline__ float dotp(const unsigned (&qp)[32], const bf16_t* __restrict__ k) {
    float s0 = 0.f, s1 = 0.f;
#pragma unroll
    for (int c = 0; c < 8; ++c) { const uint4 w = *(const uint4*)(k + 8 * c);
        s0 = fmaf(QLO(qp[4 * c]), QLO(w.x), s0); s1 = fmaf(QHI(qp[4 * c]), QHI(w.x), s1); s0 = fmaf(QLO(qp[4 * c + 1]), QLO(w.y), s0); s1 = fmaf(QHI(qp[4 * c + 1]), QHI(w.y), s1);
        s0 = fmaf(QLO(qp[4 * c + 2]), QLO(w.z), s0); s1 = fmaf(QHI(qp[4 * c + 2]), QHI(w.z), s1); s0 = fmaf(QLO(qp[4 * c + 3]), QLO(w.w), s0); s1 = fmaf(QHI(qp[4 * c + 3]), QHI(w.w), s1); }
    return (s0 + s1) * 0.125f;
}
__device__ __forceinline__ float dotp(const unsigned (&qp)[32], const float* __restrict__ k) {
    float s0 = 0.f, s1 = 0.f;
#pragma unroll
    for (int c = 0; c < 16; ++c) { const float4 w = *(const float4*)(k + 4 * c);
        s0 = fmaf(QLO(qp[2 * c]), w.x, s0); s1 = fmaf(QHI(qp[2 * c]), w.y, s1); s0 = fmaf(QLO(qp[2 * c + 1]), w.z, s0); s1 = fmaf(QHI(qp[2 * c + 1]), w.w, s1); }
    return (s0 + s1) * 0.125f;
}

template <class L>
__device__ __forceinline__ void cmp_unit(LAS unsigned char* lds, const typename L::T* H, const float* __restrict__ pe, const float* __restrict__ w1, const float* __restrict__ b1,
                                         const float* __restrict__ w2, float* KCV, int unit) {
    const int tid = fresh_tid(), which = unit >> 8, b = (unit >> 6) & 3, n0 = (unit & 63) * 8;
    LAS float* blk = (LAS float*)lds;
    LAS float* hid = (LAS float*)(lds + 65536);
    const typename L::T* src = H + (size_t)(b * S_) * L::P + L::KC + which * 64;
    for (int i = tid; i < 8 * 2048; i += NTHR) { const int nn = i >> 11, e = i & 2047, p = e >> 6, d = e & 63; const int n = n0 + nn;
        blk[i] = n < NCMP ? ldf(src + (size_t)(n * 16 + p) * L::P + d) + pe[which * 2048 + e] : 0.f; }
    __syncthreads();
    {
        const int j = tid & 255, half = tid >> 8;
        float acc[4] = {0.f, 0.f, 0.f, 0.f};
        const float* w = w1 + (size_t)which * 2048 * 256 + j;
        const LAS float* bb = blk + half * 4 * 2048;
        for (int i = 0; i < 2048; ++i) { const float wv = w[(size_t)i * 256];
#pragma unroll
            for (int r = 0; r < 4; ++r) acc[r] = fmaf(bb[r * 2048 + i], wv, acc[r]); }
        const float bj = b1[which * 256 + j];
#pragma unroll
        for (int r = 0; r < 4; ++r) { const float a = acc[r] + bj; hid[(half * 4 + r) * 256 + j] = 0.5f * a * (1.0f + tanhf(0.7978845608028654f * (a + 0.044715f * a * a * a))); }
    }
    __syncthreads();
    {
        const int nn = tid >> 6, d = tid & 63;
        float o = 0.f;
        const float* w2p = w2 + (size_t)which * 256 * 64 + d;
        for (int j = 0; j < 256; ++j) o = fmaf(hid[nn * 256 + j], w2p[j * 64], o);
        if (n0 + nn < NCMP) KCV[(((size_t)which * B_ + b) * NCMP + n0 + nn) * 64 + d] = o;
    }
    __syncthreads();
}
template <class L>
__device__ __forceinline__ void kmean_unit(LAS unsigned char* lds, const typename L::T* H, float* KM, int unit) {
    const int tid = fresh_tid(), b = unit >> 7, h = (unit >> 5) & 3, j = unit & 31, d = tid & 63, g = tid >> 6;
    LAS float* part = (LAS float*)lds;
    const typename L::T* src = H + (size_t)(b * S_ + j * 256) * L::P + L::KM + h * 64 + d;
    float s = 0.f;
    for (int r = g; r < 256; r += 8) s += ldf(src + (size_t)r * L::P);
    part[g * 64 + d] = s;
    __syncthreads();
    if (tid < 64) { float t = 0.f;
#pragma unroll
        for (int gg = 0; gg < 8; ++gg) t += part[gg * 64 + tid];
        KM[((size_t)(b * 4 + h) * 32 + j) * 64 + tid] = t * (1.0f / 256.0f); }
    __syncthreads();
}
template <class L>
__device__ __forceinline__ void conv_unit(LAS unsigned char* lds, const typename L::T* H, const float* __restrict__ wdw, const float* __restrict__ bdw, const float* __restrict__ lng,
                                          const float* __restrict__ lnb, const float* __restrict__ wpw, bf16_t* MIX, int unit) {
    const int tid = fresh_tid(), g0 = unit * 16, tb = g0 & (S_ - 1);
    LAS float* Hs = (LAS float*)lds;
    LAS float* Ys = (LAS float*)(lds + 46 * 1024);
    for (int i = tid; i < 46 * 256; i += NTHR) {
        const int r = i >> 8, c = i & 255, dt = r - 30;
        float v = 0.f;
        if (tb + dt >= 0) { const typename L::T* hr = H + (size_t)(g0 + dt) * L::P + L::CV; const float a = ldf(hr + c), g = ldf(hr + 256 + c); v = a * sigmoidf_(g); }
        Hs[i] = v;
    }
    __syncthreads();
    {
        const int c = tid & 255, half = tid >> 8;
        float w[31];
#pragma unroll
        for (int k = 0; k < 31; ++k) w[k] = wdw[k * 256 + c];
        const float bb = bdw[c];
        for (int i = 0; i < 8; ++i) {
            const int tl = half * 8 + i;
            float acc = 0.f;
#pragma unroll
            for (int k = 0; k < 31; ++k) acc = fmaf(Hs[(tl + k) * 256 + c], w[k], acc);
            Ys[tl * 256 + c] = acc + bb;
        }
    }
    __syncthreads();
    {
        const int wv = tid >> 6, lane = tid & 63;
        for (int i = 0; i < 2; ++i) {
            const int tl = wv * 2 + i;
            float v[4]; float s = 0.f;
#pragma unroll
            for (int j = 0; j < 4; ++j) { v[j] = Ys[tl * 256 + lane + 64 * j]; s += v[j]; }
#pragma unroll
            for (int o = 1; o < 64; o <<= 1) s += __shfl_xor(s, o);
            const float mu = s * (1.0f / 256.0f); float s2 = 0.f;
#pragma unroll
            for (int j = 0; j < 4; ++j) { v[j] -= mu; s2 += v[j] * v[j]; }
#pragma unroll
            for (int o = 1; o < 64; o <<= 1) s2 += __shfl_xor(s2, o);
            const float rstd = 1.0f / sqrtf(s2 * (1.0f / 256.0f) + 1e-5f);
#pragma unroll
            for (int j = 0; j < 4; ++j) { const int c = lane + 64 * j; const float y = v[j] * rstd * lng[c] + lnb[c]; Ys[tl * 256 + c] = y * sigmoidf_(y); }
        }
    }
    __syncthreads();
    {
        const int n = tid & 255, half = tid >> 8;
        float acc[8];
#pragma unroll
        for (int i = 0; i < 8; ++i) acc[i] = 0.f;
        for (int k = 0; k < 256; k += 4) {
            const float w0 = wpw[(k + 0) * 256 + n], w1 = wpw[(k + 1) * 256 + n], w2 = wpw[(k + 2) * 256 + n], w3 = wpw[(k + 3) * 256 + n];
#pragma unroll
            for (int i = 0; i < 8; ++i) { const f32x4_t y = *(const LAS f32x4_t*)&Ys[(half * 8 + i) * 256 + k]; acc[i] = fmaf(y.x, w0, acc[i]); acc[i] = fmaf(y.y, w1, acc[i]); acc[i] = fmaf(y.z, w2, acc[i]); acc[i] = fmaf(y.w, w3, acc[i]); }
        }
#pragma unroll
        for (int i = 0; i < 8; ++i) MIX[(size_t)(g0 + half * 8 + i) * DM + 512 + n] = (bf16_t)f2bf(acc[i]);
    }
    __syncthreads();
}
template <class L>
__device__ __forceinline__ void hgrn1_unit(LAS unsigned char* lds, const typename L::T* H, const float* __restrict__ lb, float* OL, float* QP, float* U, float* Dg, int unit) {
    const int tid = fresh_tid(), v = tid & 63, kg = tid >> 6, k0 = kg * 8, b = unit >> 6, h = (unit >> 4) & 3, seg = unit & 15;
    LAS float* Fl = (LAS float*)lds; LAS float* Ql = Fl + HT * 64; LAS float* Vl = Ql + HT * 64; LAS float* QPl = Vl + HT * 64; LAS float* Op = QPl + HT * 64;
    float s[8];
#pragma unroll
    for (int i = 0; i < 8; ++i) s[i] = 0.f;
    float P = 1.0f;
    for (int c = 0; c < HSEG / HT; ++c) {
        const size_t tb = (size_t)b * S_ + seg * HSEG + c * HT;
        for (int idx = tid; idx < HT * 64; idx += NTHR) {
            const int tt = idx >> 6, cc = idx & 63; const typename L::T* hr = H + (tb + tt) * L::P;
            const float lbv = lb[h * 64 + cc];
            Fl[idx] = lbv + (1.0f - lbv) * sigmoidf_(ldf(hr + L::FH + h * 64 + cc));
            Ql[idx] = ldf(hr + L::QH + h * 64 + cc);
            Vl[idx] = ldf(hr + L::IH + h * 64 + cc);
        }
        __syncthreads();
        if (tid < 64) { for (int tt = 0; tt < HT; ++tt) { P *= Fl[tt * 64 + tid]; QPl[tt * 64 + tid] = Ql[tt * 64 + tid] * P; } }
        for (int tt = 0; tt < HT; ++tt) {
            const float vv = Vl[tt * 64 + v];
            const f32x4_t fa = *(const LAS f32x4_t*)&Fl[tt * 64 + k0], fb = *(const LAS f32x4_t*)&Fl[tt * 64 + k0 + 4];
            const f32x4_t qa = *(const LAS f32x4_t*)&Ql[tt * 64 + k0], qb = *(const LAS f32x4_t*)&Ql[tt * 64 + k0 + 4];
            const float f[8] = {fa.x, fa.y, fa.z, fa.w, fb.x, fb.y, fb.z, fb.w}, q[8] = {qa.x, qa.y, qa.z, qa.w, qb.x, qb.y, qb.z, qb.w};
            float o0 = 0.f, o1 = 0.f;
#pragma unroll
            for (int i = 0; i < 8; i += 2) {
                s[i] = fmaf(f[i], s[i], (1.0f - f[i]) * vv); o0 = fmaf(q[i], s[i], o0);
                s[i + 1] = fmaf(f[i + 1], s[i + 1], (1.0f - f[i + 1]) * vv); o1 = fmaf(q[i + 1], s[i + 1], o1);
            }
            Op[(kg * HT + tt) * 64 + v] = o0 + o1;
        }
        __syncthreads();
        for (int idx = tid; idx < HT * 64; idx += NTHR) {
            const int tt = idx >> 6, cc = idx & 63;
            float o = 0.f;
#pragma unroll
            for (int g = 0; g < 8; ++g) o += Op[(g * HT + tt) * 64 + cc];
            OL[(tb + tt) * 256 + h * 64 + cc] = o;
            QP[(tb + tt) * 256 + h * 64 + cc] = QPl[idx];
        }
        __syncthreads();
    }
    float* Uu = U + (size_t)unit * 4096;
#pragma unroll
    for (int i = 0; i < 8; ++i) Uu[(k0 + i) * 64 + v] = s[i];
    if (tid < 64) Dg[unit * 64 + tid] = P;
}
template <class L>
__device__ __forceinline__ void hgrn2_unit(const typename L::T* H, const float* __restrict__ OL, const float* __restrict__ QP, const float* __restrict__ U, const float* __restrict__ Dg,
                                           const float* __restrict__ ng, bf16_t* MIX, int unit) {
    const int tid = fresh_tid(), v = tid & 63, wv = tid >> 6, b = unit >> 6, h = (unit >> 4) & 3, seg = unit & 15;
    float Sr[64];
#pragma unroll
    for (int k = 0; k < 64; ++k) Sr[k] = 0.f;
    for (int j = 0; j < seg; ++j) {
        const float* Uu = U + (size_t)(unit - seg + j) * 4096; const float* Dd = Dg + (unit - seg + j) * 64;
#pragma unroll
        for (int k = 0; k < 64; ++k) Sr[k] = fmaf(Dd[k], Sr[k], Uu[k * 64 + v]);
    }
    const float gn = ng[h * 64 + v];
    for (int i = 0; i < HSEG / 8; ++i) {
        const size_t t = (size_t)b * S_ + seg * HSEG + i * 8 + wv;
        const float* qp = QP + t * 256 + h * 64;
        float o = OL[t * 256 + h * 64 + v];
#pragma unroll
        for (int k = 0; k < 64; k += 4) { const float4 qv = *(const float4*)(qp + k); o = fmaf(qv.x, Sr[k], o); o = fmaf(qv.y, Sr[k + 1], o); o = fmaf(qv.z, Sr[k + 2], o); o = fmaf(qv.w, Sr[k + 3], o); }
        float ss = o * o;
#pragma unroll
        for (int d = 1; d < 64; d <<= 1) ss += __shfl_xor(ss, d);
        const float r = 1.0f / sqrtf(ss * (1.0f / 64.0f) + 1e-6f);
        const float g = ldf(H + t * L::P + L::GH + h * 64 + v);
        MIX[t * DM + 768 + h * 64 + v] = (bf16_t)f2bf(o * r * gn * sigmoidf_(g));
    }
}
template <class L>
__device__ __forceinline__ void nsa_unit_valu(LAS unsigned char* lds, const typename L::T* H, const float* __restrict__ KCV, const float* __restrict__ tab, float* RES, bf16_t* MIX, int unit) {
    const int tid = fresh_tid(), half = tid >> 8, t8 = tid & 255, tl = t8 >> 2, h = t8 & 3, b = unit >> 6, ib = unit & 63, blk = half ? 127 - ib : ib, t = blk * 64 + tl;
    LAS float* imp = (LAS float*)lds + half * 64 * 129;
    LAS unsigned char* selm = lds + 2 * 64 * 129 * 4 + half * 64 * 128;
    const typename L::T* Hb = H + (size_t)b * S_ * L::P;
    const typename L::T* hrow = Hb + (size_t)t * L::P;
    const float* KC = KCV + (size_t)(0 * B_ + b) * NCMP * 64; const float* VC = KCV + (size_t)(1 * B_ + b) * NCMP * 64;
    for (int i = t8; i < 64 * 129; i += 256) imp[i] = 0.f;
    unsigned q[32];
    load_qp(q, hrow + L::QN + h * 64);
    const float g0 = sigmoidf_(ldf(hrow + L::GN + h * 3 + 0)), g1 = sigmoidf_(ldf(hrow + L::GN + h * 3 + 1)), g2 = sigmoidf_(ldf(hrow + L::GN + h * 3 + 2));
    const float* tb = tab + h * 32;
    float* rrow = RES + ((size_t)b * S_ + t) * 256 + h * 64;
    __syncthreads();
    float o[64]; float m, l;
    const int cnt = t >= 31 ? (t - 31) / 16 + 1 : 0;
    m = -INFINITY; l = 0.f;
#pragma unroll
    for (int d = 0; d < 64; ++d) o[d] = 0.f;
    for (int n = 0; n < cnt; ++n) {
        const float s = dotp(q, KC + (size_t)n * 64) + tb[rel_bucket(t - (16 * n + 31))];
        osm_step(s, VC + (size_t)n * 64, m, l, o);
    }
    {
        const float inv = cnt > 0 ? 1.0f / fmaxf(l, 1e-30f) : 0.f;
#pragma unroll
        for (int d = 0; d < 64; ++d) rrow[d] = g0 * o[d] * inv;
        for (int n = 0; n < cnt; ++n) {
            const float s = dotp(q, KC + (size_t)n * 64) + tb[rel_bucket(t - (16 * n + 31))];
            const float p = expf(s - m) * inv;
            const int j = n >> 2;
            if ((n & 3) < 3) atomicAdd((float*)&imp[tl * 129 + j], p);
            else { atomicAdd((float*)&imp[tl * 129 + j], 0.5f * p); atomicAdd((float*)&imp[tl * 129 + j + 1], 0.5f * p); }
        }
    }
    __syncthreads();
    for (int jj = 0; jj < 32; ++jj) {
        const int j = h * 32 + jj;
        const bool fj = (j == 0) || (j == blk) || (j == blk - 1);
        const float vj = fj ? BIGF : (j <= blk ? imp[tl * 129 + j] : -BIGF);
        int rank = 0;
        for (int i = 0; i < 128; ++i) {
            const bool fi = (i == 0) || (i == blk) || (i == blk - 1);
            const float vi = fi ? BIGF : (i <= blk ? imp[tl * 129 + i] : -BIGF);
            rank += (vi > vj || (vi == vj && i < j)) ? 1 : 0;
        }
        selm[tl * 128 + j] = (rank < 16 && j <= blk) ? 1 : 0;
    }
    __syncthreads();
    m = -INFINITY; l = 0.f;
#pragma unroll
    for (int d = 0; d < 64; ++d) o[d] = 0.f;
    for (int j = 0; j <= blk; ++j) {
        if (selm[tl * 128 + j]) {
            for (int p = 0; p < 64; ++p) {
                const int pos = j * 64 + p;
                if (pos <= t) {
                    const float s = dotp(q, Hb + (size_t)pos * L::P + L::KS) + tb[rel_bucket(t - pos)];
                    osm_step(s, Hb + (size_t)pos * L::P + L::VS, m, l, o);
                }
            }
        }
    }
    {
        const float inv = 1.0f / fmaxf(l, 1e-30f);
#pragma unroll
        for (int d = 0; d < 64; ++d) rrow[d] += g1 * o[d] * inv;
    }
    m = -INFINITY; l = 0.f;
#pragma unroll
    for (int d = 0; d < 64; ++d) o[d] = 0.f;
    for (int pos = (t - 511 > 0 ? t - 511 : 0); pos <= t; ++pos) {
        const float s = dotp(q, Hb + (size_t)pos * L::P + L::KW) + tb[rel_bucket(t - pos)];
        osm_step(s, Hb + (size_t)pos * L::P + L::VW, m, l, o);
    }
    {
        const float inv = 1.0f / fmaxf(l, 1e-30f);
#pragma unroll
        for (int d = 0; d < 64; ++d) o[d] = rrow[d] + g2 * o[d] * inv;
        store_row64(MIX + ((size_t)b * S_ + t) * DM + h * 64, o, 1.0f);
    }
    __syncthreads();
}
template <class L>
__device__ __forceinline__ void moba_unit_valu(const typename L::T* H, const float* __restrict__ KMb, const float* __restrict__ tab, bf16_t* MIX, int unit) {
    const int tid = fresh_tid(), tl = tid >> 2, h = tid & 3, b = unit >> 6, t = (unit & 63) * 128 + tl, own = t >> 8;
    const typename L::T* Hb = H + (size_t)b * S_ * L::P;
    const float* KM = KMb + (size_t)b * 4 * 32 * 64;
    unsigned q[32];
    load_qp(q, Hb + (size_t)t * L::P + L::QM + h * 64);
    const float* tb = tab + h * 32;
    float g0 = -BIGF, g1 = -BIGF, g2 = -BIGF; int i0 = 0, i1 = 1, i2 = 2;
    for (int j = 0; j < own; ++j) {
        const float g = dotp(q, KM + (size_t)(h * 32 + j) * 64);
        if (g > g0) { g2 = g1; i2 = i1; g1 = g0; i1 = i0; g0 = g; i0 = j; }
        else if (g > g1) { g2 = g1; i2 = i1; g1 = g; i1 = j; }
        else if (g > g2) { g2 = g; i2 = j; }
    }
    float o[64]; float m = -INFINITY, l = 0.f;
#pragma unroll
    for (int d = 0; d < 64; ++d) o[d] = 0.f;
    for (int sidx = 0; sidx < 3; ++sidx) {
        const float gv = sidx == 0 ? g0 : (sidx == 1 ? g1 : g2);
        const int jb = sidx == 0 ? i0 : (sidx == 1 ? i1 : i2);
        if (gv > -0.5f * BIGF) {
            for (int p = 0; p < 256; ++p) {
                const int pos = jb * 256 + p;
                const float s = dotp(q, Hb + (size_t)pos * L::P + L::KM + h * 64) + tb[rel_bucket(t - pos)];
                osm_step(s, Hb + (size_t)pos * L::P + L::VM + h * 64, m, l, o);
            }
        }
    }
    for (int pos = own * 256; pos <= t; ++pos) {
        const float s = dotp(q, Hb + (size_t)pos * L::P + L::KM + h * 64) + tb[rel_bucket(t - pos)];
        osm_step(s, Hb + (size_t)pos * L::P + L::VM + h * 64, m, l, o);
    }
    store_row64(MIX + ((size_t)b * S_ + t) * DM + 256 + h * 64, o, 1.0f / fmaxf(l, 1e-30f));
}

struct Frame {
    LAS unsigned char* lds; volatile LAS unsigned* MISC; unsigned* ctl;
    int tid, lane, wave, vcu, G;
};
__device__ __forceinline__ void transpose_item(const float* __restrict__ W, int K, int N, bf16_t* WT, LAS float* scr, int item, int lane, int shift_at, int shift) {
    const int nblk = (N + 31) / 32, kb = item / nblk, nb = item % nblk, k0 = 64 * kb, n0 = 32 * nb;
    const int nl = n0 + (lane & 31);
#pragma unroll 8
    for (int i = 0; i < 32; ++i) { const int kk = 2 * i + (lane >> 5); scr[kk * 33 + (lane & 31)] = nl < N ? W[(size_t)(k0 + kk) * N + nl] : 0.f; }
    asm volatile("s_waitcnt lgkmcnt(0)" ::: "memory");
    const int c = lane & 7;
#pragma unroll
    for (int j = 0; j < 4; ++j) { const int n = (lane >> 3) + 8 * j; const LAS float* s = scr + (8 * c) * 33 + n; const int ng = n0 + n;
        if (ng < N) { uint4 o; o.x = pk2(s[0 * 33], s[1 * 33]); o.y = pk2(s[2 * 33], s[3 * 33]); o.z = pk2(s[4 * 33], s[5 * 33]); o.w = pk2(s[6 * 33], s[7 * 33]);
            *(uint4*)(WT + (size_t)(ng + (ng >= shift_at ? shift : 0)) * K + k0 + 8 * c) = o; } }
    asm volatile("s_waitcnt lgkmcnt(0)" ::: "memory");
}
__device__ __forceinline__ void ln_row(const float* xrow, const float* __restrict__ g, const float* __restrict__ bta, float* orow, bf16_t* brow, int lane) {
    typedef float f32x4 __attribute__((ext_vector_type(4)));
    const f32x4* xr = (const f32x4*)xrow + lane;
    f32x4 v[4]; float s = 0.f;
#pragma unroll
    for (int j = 0; j < 4; ++j) { v[j] = xr[64 * j]; s += (v[j].x + v[j].y) + (v[j].z + v[j].w); }
#pragma unroll
    for (int o = 1; o < 64; o <<= 1) s += __shfl_xor(s, o);
    const float mean = s * (1.f / DM); float s2 = 0.f;
#pragma unroll
    for (int j = 0; j < 4; ++j) { v[j] = v[j] - mean; s2 += (v[j].x * v[j].x + v[j].y * v[j].y) + (v[j].z * v[j].z + v[j].w * v[j].w); }
#pragma unroll
    for (int o = 1; o < 64; o <<= 1) s2 += __shfl_xor(s2, o);
    const float rstd = 1.f / sqrtf(s2 * (1.f / DM) + 1e-5f);
#pragma unroll
    for (int j = 0; j < 4; ++j) { const f32x4 gg = ((const f32x4*)g)[lane + 64 * j], bb = ((const f32x4*)bta)[lane + 64 * j];
        const f32x4 y = v[j] * rstd * gg + bb;
        ((f32x4*)orow)[lane + 64 * j] = y;
        ((unsigned long long*)brow)[lane + 64 * j] = (unsigned long long)pk2(y.x, y.y) | ((unsigned long long)pk2(y.z, y.w) << 32); }
}

struct Args { const float* in[21]; float* out; unsigned char* ws; int ph_lo, ph_hi; };
constexpr int NPHASE = 1 + 8 * DEPTH;

__global__ void __launch_bounds__(NTHR, 2) mega_fwd(Args args) {
    extern __shared__ __attribute__((aligned(16))) unsigned char lds_raw[];
    Frame F;
    F.lds = (LAS unsigned char*)lds_raw;
    F.MISC = (volatile LAS unsigned*)(F.lds + MISC_OFF);
    F.tid = threadIdx.x; F.lane = F.tid & 63; F.wave = __builtin_amdgcn_readfirstlane(F.tid >> 6);
    F.G = gridDim.x; { const int bx = blockIdx.x; F.vcu = (F.G % 8 == 0) ? (bx % 8) * (F.G / 8) + bx / 8 : bx; }
    unsigned char* ws = args.ws;
    F.ctl = (unsigned*)(ws + WS_CTL);
    const float* x = args.in[0];       const float* w_in = args.in[1];
    const float* cmp_pe = args.in[2];  const float* cmp_w1 = args.in[3];  const float* cmp_b1 = args.in[4];  const float* cmp_w2 = args.in[5];
    const float* dw_w = args.in[6];    const float* dw_b = args.in[7];    const float* cln_g = args.in[8];   const float* cln_b = args.in[9];
    const float* pw_w = args.in[10];   const float* lb_logits = args.in[11]; const float* hn_g = args.in[12]; const float* w_out = args.in[13];
    const float* ln1_g = args.in[14];  const float* ln1_b = args.in[15];  const float* w_ff1 = args.in[16];  const float* w_ff2 = args.in[17];
    const float* ln2_g = args.in[18];  const float* ln2_b = args.in[19];  const float* rel = args.in[20];
    float* out = args.out;
    bf16_t* WIN = (bf16_t*)(ws + WS_WIN); bf16_t* WOUT = (bf16_t*)(ws + WS_WOUT); bf16_t* W1 = (bf16_t*)(ws + WS_W1); bf16_t* W2 = (bf16_t*)(ws + WS_W2);
    bf16_t* XB = (bf16_t*)(ws + WS_XB); bf16_t* HB = (bf16_t*)(ws + WS_H); bf16_t* MIX = (bf16_t*)(ws + WS_MIX); bf16_t* HFF = (bf16_t*)(ws + WS_HFF);
    float* KCV = (float*)(ws + WS_KCV); float* KM = (float*)(ws + WS_KM); float* OL = (float*)(ws + WS_OL); float* QP = (float*)(ws + WS_QP);
    float* U = (float*)(ws + WS_U); float* Dg = (float*)(ws + WS_DG); float* LBS = (float*)(ws + WS_LBS); float* RES = (float*)(ws + WS_RES);

    for (int u = F.tid; u < (LDS_BYTES - LDSCTL_OFF) / 4; u += NTHR) ((LAS unsigned*)(F.lds + LDSCTL_OFF))[u] = 0u;
    __syncthreads();
    XcdBarrier bar = xcd_barrier_post((unsigned*)(F.ctl + CW_BAR), F.MISC + 8);
    const int lo = args.ph_lo, hi = args.ph_hi;
#define IN(k) (lo <= (k) && (k) < hi)
#define SEAM(k) do { if (IN(k) && IN((k) + 1)) xcd_barrier(bar); } while (0)

    if (IN(0)) {
        const int tid = fresh_tid(), lane = tid & 63, wave = __builtin_amdgcn_readfirstlane(tid >> 6);
        LAS float* scr = (LAS float*)(F.lds + wave * 16384);
        const int gw = F.vcu * NWAVES + wave, NGW = F.G * NWAVES;
        constexpr int I_IN = 16 * 93, I_OUT = 16 * 32, I_1 = 16 * 128, I_2 = 64 * 32;
        constexpr int NITEMS = DEPTH * (I_IN + I_OUT + I_1 + I_2);
        for (int it = gw; it < NITEMS; it += NGW) {
            int r = it; const int l = r / (I_IN + I_OUT + I_1 + I_2); r -= l * (I_IN + I_OUT + I_1 + I_2);
            if (r < I_IN) { transpose_item(w_in + (size_t)l * DM * INC, DM, INC, WIN + (size_t)l * HP * DM, scr, r, lane, SHIFT_AT, SHIFT); continue; } r -= I_IN;
            if (r < I_OUT) { transpose_item(w_out + (size_t)l * DM * DM, DM, DM, WOUT + (size_t)l * DM * DM, scr, r, lane, 1 << 30, 0); continue; } r -= I_OUT;
            if (r < I_1) { transpose_item(w_ff1 + (size_t)l * DM * FF, DM, FF, W1 + (size_t)l * FF * DM, scr, r, lane, 1 << 30, 0); continue; } r -= I_1;
            transpose_item(w_ff2 + (size_t)l * FF * DM, FF, DM, W2 + (size_t)l * DM * FF, scr, r, lane, 1 << 30, 0);
        }
        for (int i = gw * 64 + lane; i < DEPTH * 116 * 128; i += NGW * 64) {
            const int l = i / (116 * 128), r = (i / 128) % 116, c = i % 128; const int row = r < 52 ? 652 + r : 3008 + (r - 52);
            *(uint4*)(WIN + ((size_t)l * HP + row) * DM + c * 8) = make_uint4(0u, 0u, 0u, 0u);
        }
        for (size_t i = (size_t)gw * 64 + lane; i < (size_t)MTOK * DM / 8; i += (size_t)NGW * 64) {
            const float4 a = ((const float4*)x)[2 * i], b = ((const float4*)x)[2 * i + 1];
            uint4 o; o.x = pk2(a.x, a.y); o.y = pk2(a.z, a.w); o.z = pk2(b.x, b.y); o.w = pk2(b.z, b.w);
            ((uint4*)XB)[i] = o;
        }
        if (blockIdx.x == 0 && tid < 256) {
            const int i = tid; const float a0 = lb_logits[i], a1 = lb_logits[256 + i], mx = fmaxf(a0, a1);
            const float e0 = expf(a0 - mx), e1 = expf(a1 - mx), p0 = e0 / (e0 + e1), p1 = e1 / (e0 + e1);
            LBS[i] = p0 - p0; LBS[256 + i] = (p0 + p1) - p0;
        }
    }
    SEAM(0);

#ifdef UNROLL_L
#pragma unroll
#endif
    for (int l = 0; l < DEPTH; ++l) {
        const int pb = 1 + 8 * l;
        const float* Xin = (l == 0) ? x : out;
        if (IN(pb + 0)) {
            pg8::Gemm g{XB, WIN + (size_t)l * HP * DM, MTOK, HP, DM}; pg8::StaticOrder S; S.init(MTOK, HP, F.G, (int)blockIdx.x);
            pg8::EpiBf16<0> E{HB, HP};
            pg8::gemm_phase<pg8::EpiBf16<0>, pg8::StaticOrder, true, true>(F.lds, g, S, E);
        }
        SEAM(pb + 0);
        if (IN(pb + 1)) {
            constexpr int N_H1 = B_ * 4 * NSEG, N_CMP = 512, N_KM = B_ * 4 * 32, N_CV = MTOK / 16;
            for (int u = F.vcu; u < N_H1 + N_CMP + N_KM + N_CV; u += F.G) {
                int r = u;
                #ifndef SKIP_H1
                if (r < N_H1) { hgrn1_unit<LayB>(F.lds, HB, LBS + l * 256, OL, QP, U, Dg, r); continue; }
#endif
                r -= N_H1;
#ifndef SKIP_CMP
                if (r < N_CMP) { cmp_unit<LayB>(F.lds, HB, cmp_pe + (size_t)l * 2 * 2048, cmp_w1 + (size_t)l * 2 * 2048 * 256, cmp_b1 + (size_t)l * 2 * 256, cmp_w2 + (size_t)l * 2 * 256 * 64, KCV, r); continue; }
#endif
                r -= N_CMP;
#ifndef SKIP_KM
                if (r < N_KM) { kmean_unit<LayB>(F.lds, HB, KM, r); continue; }
#endif
                r -= N_KM;
#ifndef SKIP_CONV
                conv_unit<LayB>(F.lds, HB, dw_w + (size_t)l * 31 * 256, dw_b + l * 256, cln_g + l * 256, cln_b + l * 256, pw_w + (size_t)l * 65536, MIX, r);
#endif
            }
        }
        SEAM(pb + 1);
        if (IN(pb + 2)) {
            constexpr int N_NSA = B_ * 64, N_MOBA = B_ * 64, N_H2 = B_ * 4 * NSEG;
            for (int u = F.vcu; u < N_NSA + N_MOBA + N_H2; u += F.G) {
                int r = u;
                #ifndef SKIP_NSA
                if (r < N_NSA) { nsa_unit_valu<LayB>(F.lds, HB, KCV, rel, RES, MIX, r); continue; }
#endif
                r -= N_NSA;
                #ifndef SKIP_MOBA
                if (r < N_MOBA) { moba_unit_valu<LayB>(HB, KM, rel + 4 * 32, MIX, r); continue; }
#endif
                r -= N_MOBA;
#ifndef SKIP_H2
                hgrn2_unit<LayB>(HB, OL, QP, U, Dg, hn_g + l * 256, MIX, r);
#endif
            }
        }
        SEAM(pb + 2);
        if (IN(pb + 3)) {
            pg8::Gemm g{MIX, WOUT + (size_t)l * DM * DM, MTOK, DM, DM}; pg8::StaticOrder S; S.init(MTOK, DM, F.G, (int)blockIdx.x);
            pg8::EpiResF32 E{Xin, out, DM, ALPHA};
            pg8::gemm_phase<pg8::EpiResF32, pg8::StaticOrder, true, true>(F.lds, g, S, E);
        }
        SEAM(pb + 3);
        if (IN(pb + 4)) {
            const int tid = fresh_tid(), lane = tid & 63, wave = __builtin_amdgcn_readfirstlane(tid >> 6);
            const int gw = F.vcu * NWAVES + wave, NGW = F.G * NWAVES;
            for (int m = gw; m < MTOK; m += NGW) ln_row(out + (size_t)m * DM, ln1_g + l * DM, ln1_b + l * DM, out + (size_t)m * DM, XB + (size_t)m * DM, lane);
        }
        SEAM(pb + 4);
        if (IN(pb + 5)) {
            pg8::Gemm g{XB, W1 + (size_t)l * FF * DM, MTOK, FF, DM}; pg8::StaticOrder S; S.init(MTOK, FF, F.G, (int)blockIdx.x);
            pg8::EpiBf16<2> E{HFF, FF};
            pg8::gemm_phase<pg8::EpiBf16<2>, pg8::StaticOrder, true, true>(F.lds, g, S, E);
        }
        SEAM(pb + 5);
        if (IN(pb + 6)) {
            pg8::Gemm g{HFF, W2 + (size_t)l * DM * FF, MTOK, DM, FF}; pg8::StaticOrder S; S.init(MTOK, DM, F.G, (int)blockIdx.x);
            pg8::EpiResF32 E{out, out, DM, ALPHA};
            pg8::gemm_phase<pg8::EpiResF32, pg8::StaticOrder, true, true>(F.lds, g, S, E);
        }
        SEAM(pb + 6);
        if (IN(pb + 7)) {
            const int tid = fresh_tid(), lane = tid & 63, wave = __builtin_amdgcn_readfirstlane(tid >> 6);
            const int gw = F.vcu * NWAVES + wave, NGW = F.G * NWAVES;
            for (int m = gw; m < MTOK; m += NGW) ln_row(out + (size_t)m * DM, ln2_g + l * DM, ln2_b + l * DM, out + (size_t)m * DM, XB + (size_t)m * DM, lane);
        }
        SEAM(pb + 7);
    }
#undef IN
#undef SEAM
}

#ifndef MK_PER_PHASE
#define MK_PER_PHASE 0
#endif
extern "C" void kernel_launch(void* const* d_in, const int* in_sizes, int n_in, void* d_out, int out_size, void* d_ws, size_t ws_size, hipStream_t stream) {
    static int grid = 0;
    if (grid == 0) {
        if (n_in != 21 || out_size != MTOK * DM || ws_size < WS_END) { fprintf(stderr, "kernel_launch: unexpected problem (n_in %d out %d ws %zu)\n", n_in, out_size, ws_size); grid = -1; return; }
        int dev = 0, cus = 0, per_cu = 0;
        if (hipGetDevice(&dev) != hipSuccess || hipDeviceGetAttribute(&cus, hipDeviceAttributeMultiprocessorCount, dev) != hipSuccess) { grid = -1; return; }
        if (hipFuncSetAttribute((const void*)mega_fwd, hipFuncAttributeMaxDynamicSharedMemorySize, LDS_BYTES) != hipSuccess) { fprintf(stderr, "kernel_launch: hipFuncSetAttribute failed\n"); grid = -1; return; }
        if (hipOccupancyMaxActiveBlocksPerMultiprocessor(&per_cu, (const void*)mega_fwd, NTHR, LDS_BYTES) != hipSuccess || per_cu < 1) { fprintf(stderr, "kernel_launch: occupancy query says %d\n", per_cu); }
        (void)hipGetLastError();
        grid = cus;
    }
    if (grid < 0) return;
    (void)hipMemsetAsync((char*)d_ws + WS_CTL, 0, CTL_ZERO_BYTES, stream);
    Args a{};
    for (int i = 0; i < 21; ++i) a.in[i] = (const float*)d_in[i];
    a.out = (float*)d_out; a.ws = (unsigned char*)d_ws;
#if MK_PER_PHASE
    for (int p = 0; p < NPHASE; ++p) { a.ph_lo = p; a.ph_hi = p + 1; hipLaunchKernelGGL(mega_fwd, dim3(grid), dim3(NTHR), LDS_BYTES, stream, a); }
#else
    a.ph_lo = 0; a.ph_hi = NPHASE;
    hipLaunchKernelGGL(mega_fwd, dim3(grid), dim3(NTHR), LDS_BYTES, stream, a);
#endif
}
```

```cpp
#include <hip/hip_runtime.h>
#include <cstdio>
#include <cstdint>
#include <cmath>

constexpr int B_ = 4, S_ = 8192, DM = 1024, DEPTH = 2, MTOK = B_ * S_;
constexpr int INC = 2956, FF = 4096, NCMP = 511;
constexpr float ALPHA = 1.4142135623730951f;
constexpr float BIGF = 1e9f;
typedef unsigned short bf16_t;
typedef float f32x4_t __attribute__((ext_vector_type(4)));
#define GAS __attribute__((address_space(1)))
#define LAS __attribute__((address_space(3)))

struct LayB { typedef bf16_t T; static constexpr int P = 3072, QN = 0, KC = 256, VC = 320, KS = 384, VS = 448, KW = 512, VW = 576, GN = 640,
              QM = 704, KM = 960, VM = 1216, CV = 1472, QH = 1984, FH = 2240, IH = 2496, GH = 2752; };
constexpr int HP = LayB::P, SHIFT_AT = 652, SHIFT = 52;

__device__ const unsigned char BUCKET_LUT[128] = {0,1,2,3,4,5,6,7,8,9,10,11,12,13,14,15,16,16,16,17,17,18,18,18,19,19,19,20,20,20,20,21,21,21,21,22,22,22,22,22,23,23,23,23,23,23,24,24,24,24,24,24,25,25,25,25,25,25,25,26,26,26,26,26,26,26,26,27,27,27,27,27,27,27,27,27,27,28,28,28,28,28,28,28,28,28,28,29,29,29,29,29,29,29,29,29,29,29,29,30,30,30,30,30,30,30,30,30,30,30,30,30,30,31,31,31,31,31,31,31,31,31,31,31,31,31,31,31};
__device__ __forceinline__ int rel_bucket(int dist) { return dist >= 128 ? 31 : (int)BUCKET_LUT[dist < 0 ? 0 : dist]; }
__device__ __forceinline__ float sigmoidf_(float x) { return 1.0f / (1.0f + expf(-x)); }
__device__ __forceinline__ float bf2f(bf16_t v) { return __uint_as_float((unsigned)v << 16); }
__device__ __forceinline__ unsigned f2bf(float f) { unsigned u = __float_as_uint(f); return (u + 0x7fffu + ((u >> 16) & 1u)) >> 16; }
__device__ __forceinline__ unsigned pk2(float lo, float hi) { return f2bf(lo) | (f2bf(hi) << 16); }
__device__ __forceinline__ float ldf(const float* p) { return *p; }
__device__ __forceinline__ float ldf(const bf16_t* p) { return bf2f(*p); }

constexpr int NWAVES = 8, NTHR = 512;
__device__ __forceinline__ int fresh_tid() { int t = threadIdx.x; asm volatile("" : "+v"(t)); return t; }
__device__ __forceinline__ void load_qp(unsigned (&qp)[32], const bf16_t* p) {
#pragma unroll
    for (int c = 0; c < 8; ++c) { const uint4 w = *(const uint4*)(p + 8 * c); qp[4 * c] = w.x; qp[4 * c + 1] = w.y; qp[4 * c + 2] = w.z; qp[4 * c + 3] = w.w; }
}
#define QLO(u) __uint_as_float((u) << 16)
#define QHI(u) __uint_as_float((u) & 0xffff0000u)
namespace pg8 {
#define PG8_LAS __attribute__((address_space(3)))
typedef unsigned short bf16_t;
typedef short bf16x8 __attribute__((ext_vector_type(8)));
typedef float f32x4 __attribute__((ext_vector_type(4)));
typedef unsigned u32x4 __attribute__((ext_vector_type(4)));
constexpr int BM = 256, BK = 64, HALF = 128, HTB = HALF * BK * 2  , STAGE_BYTES = 8 * HTB, NXCD = 8, WGM = 8;

__host__ __device__ __forceinline__ int lds_byte(int r, int c) { const int st = (r >> 4) * 2 + (c >> 5), rr = r & 15, cc = c & 31, ob = rr * 64 + cc * 2; return st * 1024 + (ob ^ (((ob >> 9) & 1) << 5)); }
__host__ __device__ __forceinline__ void stage_rc(int b, int& R, int& C) { const int st = b / 1024, sb = b % 1024, swz = sb ^ (((sb >> 9) & 1) << 5); R = (st >> 1) * 16 + swz / 64; C = (st & 1) * 32 + (swz % 64) / 2; }
__host__ __device__ __forceinline__ int perm32(int rho) { const int n = rho >> 4, i = rho & 15; return 8 * (i >> 2) + 4 * n + (i & 3); }

struct Unit { int pm, pn; };
struct Gemm { const bf16_t* A; const bf16_t* Bt; int M, N, K; };

struct StaticOrder {
    int nM, nN, nwg, G, c;
    __host__ __device__ void init(int M, int N, int G_, int c_) { nM = M / BM; nN = N / BM; nwg = nM * nN; G = G_; c = c_; }
    __host__ __device__ bool next(int i, Unit& u) const {
        const long L = (long)i * G + c; if (L >= nwg) return false;
        int wgid = (int)L; { const int q = nwg / NXCD, r = nwg % NXCD, xcd = wgid % NXCD, off = wgid / NXCD; wgid = (xcd < r ? xcd * (q + 1) : r * (q + 1) + (xcd - r) * q) + off; }
        const int nig = WGM * nN, gid = wgid / nig, fm = gid * WGM, gsz = (nM - fm) < WGM ? (nM - fm) : WGM;
        u.pm = fm + ((wgid % nig) % gsz); u.pn = (wgid % nig) / gsz; return true;
    }
    __device__ __forceinline__ void a_ready(const Unit&) const {}
    __device__ __forceinline__ void done(const Unit&) const {}
};


__device__ __forceinline__ unsigned cvt_pk_bf16(float lo, float hi) { unsigned r; asm volatile("v_cvt_pk_bf16_f32 %0, %1, %2" : "=v"(r) : "v"(lo), "v"(hi)); return r; }
template <int ACT  > struct EpiBf16 {
    static constexpr bool PERM = true, AFTER_DRAIN = false;
    bf16_t* O; int ldc;
    __device__ __forceinline__ void operator()(const f32x4 (&acc)[2][2][4][2], const Unit& u, int wr, int wc, int fr, int fq) const {
        const int row0 = u.pm * BM + wr * 64 + fr; const int col0 = u.pn * BM + wc * 32 + 8 * fq;
#pragma unroll
        for (int ai = 0; ai < 2; ++ai)
#pragma unroll
            for (int m = 0; m < 4; ++m) { bf16_t* rowp = O + (size_t)(row0 + ai * HALF + m * 16) * ldc + col0;
#pragma unroll
                for (int bj = 0; bj < 2; ++bj) { f32x4 v0 = acc[ai][bj][m][0], v1 = acc[ai][bj][m][1];
                    if (ACT == 2) {
#pragma unroll
                        for (int e = 0; e < 4; ++e) { const float a = v0[e] > 0.f ? v0[e] : 0.f, b = v1[e] > 0.f ? v1[e] : 0.f; v0[e] = a * a; v1[e] = b * b; } }
                    u32x4 w; w.x = cvt_pk_bf16(v0[0], v0[1]); w.y = cvt_pk_bf16(v0[2], v0[3]); w.z = cvt_pk_bf16(v1[0], v1[1]); w.w = cvt_pk_bf16(v1[2], v1[3]);
                    *(u32x4*)(rowp + bj * HALF) = w; } }
    }
};
struct EpiResF32 {
    static constexpr bool PERM = false, AFTER_DRAIN = false;
    const float* base; float* out; int ldc; float alpha;
    __device__ __forceinline__ void operator()(const f32x4 (&acc)[2][2][4][2], const Unit& u, int wr, int wc, int fr, int fq) const {
        const int col0 = u.pn * BM + wc * 32 + 4 * fq;
#pragma unroll
        for (int ai = 0; ai < 2; ++ai)
#pragma unroll
            for (int m = 0; m < 4; ++m) { const int r = ai * HALF + wr * 64 + m * 16 + fr; const size_t off = (size_t)(u.pm * BM + r) * ldc + col0;
#pragma unroll
                for (int bj = 0; bj < 2; ++bj)
#pragma unroll
                    for (int n = 0; n < 2; ++n) { const f32x4 bs = *(const f32x4*)(base + off + bj * HALF + n * 16); *(f32x4*)(out + off + bj * HALF + n * 16) = bs * alpha + acc[ai][bj][m][n]; }
                if (m & 1) asm volatile("" ::: "memory"); }
    }
};

template <class Epi, class Sched, bool ALIGN_EPI = false, bool SP2 = false>
__device__ __forceinline__ void gemm_phase(PG8_LAS unsigned char* lds, const Gemm g, const Sched& S, const Epi& E) {
    int tid_ = threadIdx.x; asm volatile("" : "+v"(tid_)); const int tid = tid_, wid = __builtin_amdgcn_readfirstlane(tid >> 6), lane = tid & 63, wr = wid >> 2, wc = wid & 3, fr = lane & 15, fq = lane >> 4;
    const int K = g.K, nt = K / BK;
    unsigned voffA[2], voffB[2];
#pragma unroll
    for (int i = 0; i < 2; ++i) { int R, C; stage_rc(tid * 16 + i * 8192, R, C); const int Rb = Epi::PERM ? ((R & ~31) + perm32(R & 31)) : R;
        voffA[i] = (unsigned)(R * K + C) * 2u; voffB[i] = (unsigned)(Rb * K + C) * 2u; }
    const size_t kstep = (size_t)(BK * 2);
    const size_t hstep = (size_t)HALF * K * 2;
    const size_t tstep = 2 * hstep;
    const unsigned ldsw = (unsigned)wid * 1024u;
    const int aoff = lds_byte(wr * 64 + fr, fq * 8), boff = lds_byte(wc * 32 + fr, fq * 8);
#define PG8_SA(b, h) (((b) * 2 + (h)) * HTB)
#define PG8_SB(b, h) ((4 + (b) * 2 + (h)) * HTB)
#define PG8_STAGE(bufoff, gbase, voff) do { _Pragma("unroll") for (int _i = 0; _i < 2; ++_i) \
        __builtin_amdgcn_global_load_lds((const unsigned*)((const char*)(gbase) + (voff)[_i]), (PG8_LAS unsigned*)(lds + (bufoff) + ldsw + _i * 8192), 16, 0, 0); } while (0)
#define PG8_LDA(dst, b, h) do { _Pragma("unroll") for (int m = 0; m < 4; ++m) _Pragma("unroll") for (int k = 0; k < 2; ++k) dst[m][k] = *(const PG8_LAS bf16x8*)(lds + PG8_SA(b, h) + aoff + m * 2048 + k * 1024); } while (0)
#define PG8_LDB(dst, b, h) do { _Pragma("unroll") for (int n = 0; n < 2; ++n) _Pragma("unroll") for (int k = 0; k < 2; ++k) dst[n][k] = *(const PG8_LAS bf16x8*)(lds + PG8_SB(b, h) + boff + n * 2048 + k * 1024); } while (0)
#define PG8_MMA(ai, bj, At, Bt) do { __builtin_amdgcn_s_setprio(1); _Pragma("unroll") for (int m = 0; m < 4; ++m) _Pragma("unroll") for (int n = 0; n < 2; ++n) _Pragma("unroll") for (int k = 0; k < 2; ++k) \
        acc[ai][bj][m][n] = __builtin_amdgcn_mfma_f32_16x16x32_bf16(Bt[n][k], At[m][k], acc[ai][bj][m][n], 0, 0, 0); __builtin_amdgcn_s_setprio(0); } while (0)
#define PG8_WAIT_V(n) asm volatile("s_waitcnt vmcnt(" #n ")" ::: "memory")
#define PG8_WAIT_L(n) asm volatile("s_waitcnt lgkmcnt(" #n ")" ::: "memory")
#define PG8_BAR __builtin_amdgcn_s_barrier()
#define PG8_SCHED __builtin_amdgcn_sched_barrier(0)
    Unit cur, nxt; int ui = 0;
    if (!S.next(0, cur)) return;
    f32x4 acc[2][2][4][2];
#pragma unroll
    for (int a = 0; a < 2; ++a)
#pragma unroll
        for (int b = 0; b < 2; ++b)
#pragma unroll
            for (int m = 0; m < 4; ++m)
#pragma unroll
                for (int n = 0; n < 2; ++n) acc[a][b][m][n] = (f32x4){0.f, 0.f, 0.f, 0.f};
    bf16x8 At[4][2], B0[2][2], B1[2][2];
    const char* cA = (const char*)g.A + (size_t)cur.pm * tstep; const char* cB = (const char*)g.Bt + (size_t)cur.pn * tstep;
    S.a_ready(cur);
    if constexpr (SP2) {
        PG8_STAGE(PG8_SB(0, 0), cB, voffB); PG8_STAGE(PG8_SB(0, 1), cB + hstep, voffB); PG8_STAGE(PG8_SA(0, 0), cA, voffA); PG8_STAGE(PG8_SA(0, 1), cA + hstep, voffA);
        if (wr == 1) PG8_BAR;
        PG8_WAIT_V(2); PG8_BAR;
        PG8_STAGE(PG8_SB(1, 0), cB + kstep, voffB); PG8_STAGE(PG8_SA(1, 0), cA + kstep, voffA); PG8_STAGE(PG8_SB(1, 1), cB + hstep + kstep, voffB);
        PG8_WAIT_V(6); PG8_BAR;
    } else {
        PG8_STAGE(PG8_SB(0, 0), cB, voffB); PG8_STAGE(PG8_SA(0, 0), cA, voffA); PG8_STAGE(PG8_SB(0, 1), cB + hstep, voffB); PG8_STAGE(PG8_SA(0, 1), cA + hstep, voffA);
        if (wr == 1) PG8_BAR;
        PG8_WAIT_V(4); PG8_BAR;
        PG8_STAGE(PG8_SB(1, 0), cB + kstep, voffB); PG8_STAGE(PG8_SA(1, 0), cA + kstep, voffA); PG8_STAGE(PG8_SB(1, 1), cB + hstep + kstep, voffB);
        PG8_WAIT_V(6); PG8_BAR;
    }
    for (;;) {
        const bool has_next = S.next(ui + 1, nxt);
        const char* nA = has_next ? (const char*)g.A + (size_t)nxt.pm * tstep : cA; const char* nB = has_next ? (const char*)g.Bt + (size_t)nxt.pn * tstep : cB;
        for (int t = 0; t < nt; t += 2) {
            const bool last = (t == nt - 2);
            const char* a1 = cA + (size_t)(t + 1) * kstep;
            const char* a2 = last ? nA : cA + (size_t)(t + 2) * kstep; const char* b2 = last ? nB : cB + (size_t)(t + 2) * kstep;
            const char* a3 = a2 + kstep; const char* b3 = b2 + kstep;
            if (last && has_next) S.a_ready(nxt);
            if constexpr (SP2) {
            PG8_LDB(B0, 0, 0); PG8_LDB(B1, 0, 1); PG8_SCHED; PG8_LDA(At, 0, 0); PG8_STAGE(PG8_SA(1, 1), a1 + hstep, voffA);
            PG8_WAIT_V(8); PG8_WAIT_L(0); PG8_BAR; PG8_MMA(0, 0, At, B0); PG8_MMA(0, 1, At, B1); PG8_BAR; PG8_SCHED;
            PG8_LDA(At, 0, 1); PG8_STAGE(PG8_SB(0, 0), b2, voffB); PG8_STAGE(PG8_SB(0, 1), b2 + hstep, voffB); PG8_STAGE(PG8_SA(0, 0), a2, voffA);
            PG8_WAIT_V(8); PG8_WAIT_L(0); PG8_BAR; PG8_MMA(1, 0, At, B0); PG8_MMA(1, 1, At, B1); PG8_BAR; PG8_SCHED;
            PG8_LDB(B0, 1, 0); PG8_LDB(B1, 1, 1); PG8_SCHED; PG8_LDA(At, 1, 0); PG8_STAGE(PG8_SA(0, 1), a2 + hstep, voffA);
            PG8_WAIT_V(8); PG8_WAIT_L(0); PG8_BAR; PG8_MMA(0, 0, At, B0); PG8_MMA(0, 1, At, B1); PG8_BAR; PG8_SCHED;
            PG8_LDA(At, 1, 1); PG8_STAGE(PG8_SB(1, 0), b3, voffB); PG8_STAGE(PG8_SB(1, 1), b3 + hstep, voffB); PG8_STAGE(PG8_SA(1, 0), a3, voffA);
            PG8_WAIT_V(8); PG8_WAIT_L(0); PG8_BAR; PG8_MMA(1, 0, At, B0); PG8_MMA(1, 1, At, B1); PG8_BAR; PG8_SCHED;
            } else {
            PG8_LDB(B0, 0, 0); PG8_SCHED; PG8_LDA(At, 0, 0); PG8_STAGE(PG8_SA(1, 1), a1 + hstep, voffA);
            PG8_WAIT_L(8); PG8_BAR; PG8_WAIT_L(0); PG8_MMA(0, 0, At, B0); PG8_BAR; PG8_SCHED;
            PG8_LDB(B1, 0, 1); PG8_STAGE(PG8_SB(0, 0), b2, voffB);
            PG8_BAR; PG8_WAIT_L(0); PG8_MMA(0, 1, At, B1); PG8_BAR;
            PG8_LDA(At, 0, 1); PG8_STAGE(PG8_SA(0, 0), a2, voffA);
            PG8_BAR; PG8_WAIT_L(0); PG8_MMA(1, 0, At, B0); PG8_BAR; PG8_SCHED;
            PG8_STAGE(PG8_SB(0, 1), b2 + hstep, voffB);
            PG8_WAIT_V(6); PG8_BAR; PG8_MMA(1, 1, At, B1); PG8_BAR;
            PG8_LDB(B0, 1, 0); PG8_SCHED; PG8_LDA(At, 1, 0); PG8_STAGE(PG8_SA(0, 1), a2 + hstep, voffA);
            PG8_WAIT_L(8); PG8_BAR; PG8_WAIT_L(0); PG8_MMA(0, 0, At, B0); PG8_BAR; PG8_SCHED;
            PG8_LDB(B1, 1, 1); PG8_STAGE(PG8_SB(1, 0), b3, voffB);
            PG8_BAR; PG8_WAIT_L(0); PG8_MMA(0, 1, At, B1); PG8_BAR;
            PG8_LDA(At, 1, 1); PG8_STAGE(PG8_SA(1, 0), a3, voffA);
            PG8_BAR; PG8_WAIT_L(0); PG8_MMA(1, 0, At, B0); PG8_BAR; PG8_SCHED;
            PG8_STAGE(PG8_SB(1, 1), b3 + hstep, voffB);
            PG8_WAIT_V(6); PG8_BAR; PG8_MMA(1, 1, At, B1); PG8_BAR;
            }
        }
        if constexpr (ALIGN_EPI) { if (wr == 0) PG8_BAR; }
        if constexpr (!Epi::AFTER_DRAIN) { E(acc, cur, wr, wc, fr, fq); S.done(cur); }
        if (!has_next) break;
#pragma unroll
        for (int a = 0; a < 2; ++a)
#pragma unroll
            for (int b = 0; b < 2; ++b)
#pragma unroll
                for (int m = 0; m < 4; ++m)
#pragma unroll
                    for (int n = 0; n < 2; ++n) acc[a][b][m][n] = (f32x4){0.f, 0.f, 0.f, 0.f};
        cur = nxt; cA = nA; cB = nB; ++ui;
        if constexpr (ALIGN_EPI) { if (wr == 1) PG8_BAR; }
    }
    PG8_WAIT_V(0);
    if constexpr (!ALIGN_EPI) { if (wr == 0) PG8_BAR; }
    PG8_BAR;
    if constexpr (Epi::AFTER_DRAIN) { E.fused(acc, cur, wr, wc, fr, fq, lds, wid, lane); S.done(cur); }
#undef PG8_SA
#undef PG8_SB
#undef PG8_STAGE
#undef PG8_LDA
#undef PG8_LDB
#undef PG8_MMA
#undef PG8_WAIT_V
#undef PG8_WAIT_L
#undef PG8_BAR
#undef PG8_SCHED
}
}

#define XB_TMO      128
#define XB_XCNT(j)  (256  + 64 * (j))
#define XB_XSUB(j)  (1280 + 64 * (j))
#define XB_XGEN(j)  (2304 + 64 * (j))
#define XB_TOP      3328
#define XB_TOPGEN   3392
#define XCD_BAR_WORDS 3456
#define XB_SPIN_CAP (1u << 26)

__device__ __forceinline__ unsigned xb_ld(unsigned* p)              { return __hip_atomic_load(p, __ATOMIC_RELAXED, __HIP_MEMORY_SCOPE_AGENT); }
__device__ __forceinline__ unsigned xb_add(unsigned* p, unsigned v) { return __hip_atomic_fetch_add(p, v, __ATOMIC_RELAXED, __HIP_MEMORY_SCOPE_AGENT); }
__device__ __forceinline__ unsigned xb_xcc_id() { return (unsigned)__builtin_amdgcn_s_getreg((3 << 11) | 20) & 0xFu; }
#define XB_SPIN(cond, bar) do { unsigned _sp = 0; while (cond) { __builtin_amdgcn_s_sleep(1); \
    if ((++_sp & 255u) == 0u) { if (xb_ld(&(bar)[XB_TMO])) break; if (_sp > XB_SPIN_CAP) { atomicAdd(&(bar)[XB_TMO], 1u); break; } } } } while (0)

struct XcdBarrier {
    unsigned* bar; unsigned x;
    volatile LAS unsigned* st;
};

__device__ __forceinline__ XcdBarrier xcd_barrier_post(unsigned* bar, volatile LAS unsigned* st) {
    XcdBarrier b; b.bar = bar; b.x = xb_xcc_id(); b.st = st;
    if (threadIdx.x == 0) (void)xb_add(&bar[XB_XCNT(b.x)], 1u);
    return b;
}
__device__ __forceinline__ void xcd_barrier_complete(unsigned* bar, unsigned x, unsigned& nloc, unsigned& nx) {
    const unsigned G = gridDim.x * gridDim.y * gridDim.z;
    unsigned sum, cnt, mine, sp = 0u;
    for (;;) {
        sum = 0u; cnt = 0u; mine = 0u;
#pragma unroll
        for (unsigned j = 0; j < 16; ++j) { const unsigned c = xb_ld(&bar[XB_XCNT(j)]); sum += c; cnt += (c > 0u) ? 1u : 0u; mine = (j == x) ? c : mine; }
        if (sum == G) break;
        __builtin_amdgcn_s_sleep(1);
        if ((++sp & 255u) == 0u) { if (xb_ld(&bar[XB_TMO])) break; if (sp > XB_SPIN_CAP) { atomicAdd(&bar[XB_TMO], 1u); break; } }
    }
    nloc = mine > 0u ? mine : 1u; nx = cnt > 0u ? cnt : 1u;
}

__device__ __forceinline__ void xcd_barrier(const XcdBarrier& b) {
    asm volatile("s_waitcnt vmcnt(0)" ::: "memory");
    __syncthreads();
    if (threadIdx.x == 0) {
        unsigned* bar = b.bar;
        __builtin_amdgcn_s_waitcnt(0);
        unsigned nloc = b.st[0], nx = b.st[1];
        if (nloc == 0u) { xcd_barrier_complete(bar, b.x, nloc, nx); b.st[0] = nloc; b.st[1] = nx; }
        const unsigned old = xb_add(&bar[XB_XSUB(b.x)], 1u);
        const unsigned gen = old / nloc;
        if (old + 1u == (gen + 1u) * nloc) {
            __builtin_amdgcn_fence(__ATOMIC_RELEASE, "agent");
            asm volatile("s_waitcnt vmcnt(0)" ::: "memory");
            const unsigned og = xb_add(&bar[XB_TOP], 1u);
            const unsigned tg = og / nx;
            if (og + 1u == (tg + 1u) * nx) xb_add(&bar[XB_TOPGEN], 1u);
            else XB_SPIN(xb_ld(&bar[XB_TOPGEN]) == tg, bar);
            __builtin_amdgcn_fence(__ATOMIC_ACQUIRE, "agent");
            xb_add(&bar[XB_XGEN(b.x)], 1u);
            asm volatile("s_waitcnt vmcnt(0)" ::: "memory");
        } else {
            XB_SPIN(xb_ld(&bar[XB_XGEN(b.x)]) == gen, bar);
            __builtin_amdgcn_fence(__ATOMIC_ACQUIRE, "agent");
            asm volatile("s_waitcnt vmcnt(0)" ::: "memory");
        }
    }
    __syncthreads();
}


constexpr size_t MiB = 1u << 20;
constexpr size_t WS_CTL = 0, CTL_ZERO_BYTES = 1 * MiB;
constexpr size_t WS_WIN = 1 * MiB;
constexpr size_t WS_WOUT = WS_WIN + 12 * MiB;
constexpr size_t WS_W1 = WS_WOUT + 4 * MiB;
constexpr size_t WS_W2 = WS_W1 + 16 * MiB;
constexpr size_t WS_XB = WS_W2 + 16 * MiB;
constexpr size_t WS_H = WS_XB + 64 * MiB;
constexpr size_t WS_MIX = WS_H + 192 * MiB;
constexpr size_t WS_HFF = WS_H;
constexpr size_t WS_KCV = WS_H + 256 * MiB;
constexpr size_t WS_KM = WS_KCV + 2 * MiB;
constexpr size_t WS_OL = WS_KM + 1 * MiB;
constexpr size_t WS_QP = WS_OL + 32 * MiB;
constexpr size_t WS_U = WS_QP + 32 * MiB;
constexpr size_t WS_DG = WS_U + 4 * MiB;
constexpr size_t WS_LBS = WS_DG + 1 * MiB;
constexpr size_t WS_RES = WS_LBS + 1 * MiB;
constexpr size_t WS_WPT = WS_RES;
constexpr size_t WS_W1CT = WS_RES + 1 * MiB;
constexpr size_t WS_END = WS_RES + 32 * MiB;
static_assert(WS_END <= 512 * MiB, "workspace map");
constexpr int CW_BAR = 4096;
constexpr int RING_BYTES = 131072, LDSCTL_OFF = RING_BYTES, MISC_OFF = LDSCTL_OFF + 320, LDS_BYTES = 147456;
constexpr int HSEG = 512, NSEG = S_ / HSEG, HT = 16;

__device__ __forceinline__ float dot64(const float (&q)[64], const float* __restrict__ k) {
    float s0 = 0.f, s1 = 0.f, s2 = 0.f, s3 = 0.f;
#pragma unroll
    for (int d = 0; d < 64; d += 4) { const float4 kv = *(const float4*)(k + d); s0 = fmaf(q[d], kv.x, s0); s1 = fmaf(q[d + 1], kv.y, s1); s2 = fmaf(q[d + 2], kv.z, s2); s3 = fmaf(q[d + 3], kv.w, s3); }
    return (s0 + s1) + (s2 + s3);
}
__device__ __forceinline__ float dot64(const float (&q)[64], const bf16_t* __restrict__ k) {
    float s0 = 0.f, s1 = 0.f, s2 = 0.f, s3 = 0.f;
#pragma unroll
    for (int c = 0; c < 8; ++c) { const uint4 w = *(const uint4*)(k + 8 * c);
        s0 = fmaf(q[8 * c + 0], __uint_as_float(w.x << 16), s0); s1 = fmaf(q[8 * c + 1], __uint_as_float(w.x & 0xffff0000u), s1);
        s2 = fmaf(q[8 * c + 2], __uint_as_float(w.y << 16), s2); s3 = fmaf(q[8 * c + 3], __uint_as_float(w.y & 0xffff0000u), s3);
        s0 = fmaf(q[8 * c + 4], __uint_as_float(w.z << 16), s0); s1 = fmaf(q[8 * c + 5], __uint_as_float(w.z & 0xffff0000u), s1);
        s2 = fmaf(q[8 * c + 6], __uint_as_float(w.w << 16), s2); s3 = fmaf(q[8 * c + 7], __uint_as_float(w.w & 0xffff0000u), s3); }
    return (s0 + s1) + (s2 + s3);
}
__device__ __forceinline__ void axpy64(float p, const float* __restrict__ v, float (&o)[64]) {
#pragma unroll
    for (int d = 0; d < 64; d += 4) { const float4 vv = *(const float4*)(v + d); o[d] = fmaf(p, vv.x, o[d]); o[d + 1] = fmaf(p, vv.y, o[d + 1]); o[d + 2] = fmaf(p, vv.z, o[d + 2]); o[d + 3] = fmaf(p, vv.w, o[d + 3]); }
}
__device__ __forceinline__ void axpy64(float p, const bf16_t* __restrict__ v, float (&o)[64]) {
#pragma unroll
    for (int c = 0; c < 8; ++c) { const uint4 w = *(const uint4*)(v + 8 * c);
        o[8 * c + 0] = fmaf(p, __uint_as_float(w.x << 16), o[8 * c + 0]); o[8 * c + 1] = fmaf(p, __uint_as_float(w.x & 0xffff0000u), o[8 * c + 1]);
        o[8 * c + 2] = fmaf(p, __uint_as_float(w.y << 16), o[8 * c + 2]); o[8 * c + 3] = fmaf(p, __uint_as_float(w.y & 0xffff0000u), o[8 * c + 3]);
        o[8 * c + 4] = fmaf(p, __uint_as_float(w.z << 16), o[8 * c + 4]); o[8 * c + 5] = fmaf(p, __uint_as_float(w.z & 0xffff0000u), o[8 * c + 5]);
        o[8 * c + 6] = fmaf(p, __uint_as_float(w.w << 16), o[8 * c + 6]); o[8 * c + 7] = fmaf(p, __uint_as_float(w.w & 0xffff0000u), o[8 * c + 7]); }
}
template <typename TV>
__device__ __forceinline__ void osm_step(float s, const TV* __restrict__ v, float& m, float& l, float (&o)[64]) {
    if (s > m) { const float f = expf(m - s); l *= f;
#pragma unroll
        for (int d = 0; d < 64; ++d) o[d] *= f;
        m = s; }
    const float p = expf(s - m); l += p;
    axpy64(p, v, o);
}
__device__ __forceinline__ void load_q64(float (&q)[64], const float* p, float sc) {
#pragma unroll
    for (int d = 0; d < 64; ++d) q[d] = p[d] * sc;
}
__device__ __forceinline__ void load_q64(float (&q)[64], const bf16_t* p, float sc) {
#pragma unroll
    for (int c = 0; c < 8; ++c) { const uint4 w = *(const uint4*)(p + 8 * c);
        q[8 * c + 0] = __uint_as_float(w.x << 16) * sc; q[8 * c + 1] = __uint_as_float(w.x & 0xffff0000u) * sc; q[8 * c + 2] = __uint_as_float(w.y << 16) * sc; q[8 * c + 3] = __uint_as_float(w.y & 0xffff0000u) * sc;
        q[8 * c + 4] = __uint_as_float(w.z << 16) * sc; q[8 * c + 5] = __uint_as_float(w.z & 0xffff0000u) * sc; q[8 * c + 6] = __uint_as_float(w.w << 16) * sc; q[8 * c + 7] = __uint_as_float(w.w & 0xffff0000u) * sc; }
}
__device__ __forceinline__ void store_row64(bf16_t* p, const float (&o)[64], float sc) {
#pragma unroll
    for (int c = 0; c < 8; ++c) { uint4 w; w.x = pk2(o[8 * c] * sc, o[8 * c + 1] * sc); w.y = pk2(o[8 * c + 2] * sc, o[8 * c + 3] * sc); w.z = pk2(o[8 * c + 4] * sc, o[8 * c + 5] * sc); w.w = pk2(o[8 * c + 6] * sc, o[8 * c + 7] * sc); *(uint4*)(p + 8 * c) = w; }
}


namespace att {
typedef short bf16x8 __attribute__((ext_vector_type(8)));
typedef short s16x4 __attribute__((ext_vector_type(4)));
typedef short v4i16_t __attribute__((ext_vector_type(4)));
typedef float f32x16 __attribute__((ext_vector_type(16)));
typedef unsigned u32x4 __attribute__((ext_vector_type(4)));
typedef float f32x2_t __attribute__((ext_vector_type(2)));
typedef __bf16 bf16x2_t __attribute__((ext_vector_type(2)));
constexpr float LOG2E = 1.4426950408889634f, C2 = 0.125f * LOG2E, NEG_INF = -INFINITY, M_INIT = -1e30f, THR = 8.0f;
constexpr int L_KV = 0, KVBUF = 16384, L_WSF = 32768, L_TABD = 34816, L_IMP = 38912, L_SEL = 72192, L_OST = 73728, L_END = 106496;
typedef LAS const unsigned char* lcp;

__device__ __forceinline__ int crow(int r, int hi) { return (r & 3) + 8 * (r >> 2) + 4 * hi; }
__device__ __forceinline__ unsigned cvtpk(float lo, float hi) { f32x2_t v = {lo, hi}; bf16x2_t b = __builtin_convertvector(v, bf16x2_t); return __builtin_bit_cast(unsigned, b); }
__device__ __forceinline__ float swapmax(float m) { auto rr = __builtin_amdgcn_permlane32_swap(__float_as_uint(m), __float_as_uint(m), false, false); return fmaxf(__uint_as_float(rr[0]), __uint_as_float(rr[1])); }
__device__ __forceinline__ float swapsum(float m) { auto rr = __builtin_amdgcn_permlane32_swap(__float_as_uint(m), __float_as_uint(m), false, false); return __uint_as_float(rr[0]) + __uint_as_float(rr[1]); }

struct KVRegs { u32x4 k, v; };
__device__ __forceinline__ void kv_load(KVRegs& R, const bf16_t* Kt, const bf16_t* Vt, int pitch, int tid_unused, bool withv) {
    const int tid = fresh_tid(), key = tid & 63, ch = tid >> 6;
    R.k = *(const u32x4*)(Kt + (size_t)key * pitch + ch * 8);
    if (withv) R.v = *(const u32x4*)(Vt + (size_t)key * pitch + ch * 8);
}
__device__ __forceinline__ void kv_store(const KVRegs& R, LAS unsigned char* buf, int tid_unused, bool withv) {
    const int tid = fresh_tid(), key = tid & 63, ch = tid >> 6;
    *(LAS u32x4*)(buf + ch * 1024 + key * 16) = R.k;
    if (withv) *(LAS u32x4*)(buf + 8192 + ((key >> 4) + 4 * (ch >> 2)) * 1024 + (key & 15) * 64 + (ch & 3) * 16) = R.v;
}
__device__ __forceinline__ void qk_tile(f32x16& p0, f32x16& p1, lcp Kb, const bf16x8 (&qr)[4], int r32_unused, int hi_unused) {
    const int ln = fresh_tid() & 63; lcp kb = Kb + (ln >> 5) * 1024 + (ln & 31) * 16;
    const f32x16 z = {0.f, 0.f, 0.f, 0.f, 0.f, 0.f, 0.f, 0.f, 0.f, 0.f, 0.f, 0.f, 0.f, 0.f, 0.f, 0.f};
    p0 = z; p1 = z;
#pragma unroll
    for (int d0 = 0; d0 < 4; ++d0) {
        const bf16x8 b0 = *(const LAS bf16x8*)(kb + d0 * 2048), b1 = *(const LAS bf16x8*)(kb + d0 * 2048 + 512);
        p0 = __builtin_amdgcn_mfma_f32_32x32x16_bf16(b0, qr[d0], p0, 0, 0, 0);
        p1 = __builtin_amdgcn_mfma_f32_32x32x16_bf16(b1, qr[d0], p1, 0, 0, 0);
    }
}
__device__ __forceinline__ s16x4 vtr(lcp p) { return __builtin_bit_cast(s16x4, __builtin_amdgcn_ds_read_tr16_b64_v4i16((LAS v4i16_t*)p)); }
__device__ __forceinline__ void pv_tile(f32x16 (&o)[2], lcp Vb, const f32x16& p0, const f32x16& p1, int lane, int hi) {
    u32x4 pw[4];
#pragma unroll
    for (int i = 0; i < 4; ++i) { pw[0][i] = cvtpk(p0[2 * i], p0[2 * i + 1]); pw[1][i] = cvtpk(p0[8 + 2 * i], p0[9 + 2 * i]); pw[2][i] = cvtpk(p1[2 * i], p1[2 * i + 1]); pw[3][i] = cvtpk(p1[8 + 2 * i], p1[9 + 2 * i]); }
    const int ln = fresh_tid() & 63; lcp vp = Vb + ((ln >> 4) & 1) * 32 + (ln & 3) * 8 + (4 * (ln >> 5) + ((ln & 15) >> 2)) * 64;
#pragma unroll
    for (int d0 = 0; d0 < 2; ++d0)
#pragma unroll
        for (int ks = 0; ks < 4; ++ks) {
            const s16x4 lo = vtr(vp + d0 * 4096 + ks * 1024), hh = vtr(vp + d0 * 4096 + ks * 1024 + 512);
            const bf16x8 vf = {lo[0], lo[1], lo[2], lo[3], hh[0], hh[1], hh[2], hh[3]};
            o[d0] = __builtin_amdgcn_mfma_f32_32x32x16_bf16(__builtin_bit_cast(bf16x8, pw[ks]), vf, o[d0], 0, 0, 0);
        }
}
__device__ __forceinline__ void bias_far(f32x16& p0, f32x16& p1, float b) {
#pragma unroll
    for (int r = 0; r < 16; ++r) { p0[r] = fmaf(p0[r], C2, b); p1[r] = fmaf(p1[r], C2, b); }
}
template <int STRIDE, int W>
__device__ __forceinline__ void bias_near(f32x16& p0, f32x16& p1, int D0, const LAS float* tabdh, bool colok, int hi) {
    int Dh = D0 - STRIDE * 4 * hi; asm volatile("" : "+v"(Dh));
#pragma unroll
    for (int r = 0; r < 16; ++r) {
        const int d0 = Dh - STRIDE * ((r & 3) + 8 * (r >> 2)), d1 = d0 - STRIDE * 32;
        const float b0 = tabdh[d0 < 0 ? 0 : (d0 > 127 ? 127 : d0)], b1 = tabdh[d1 < 0 ? 0 : (d1 > 127 ? 127 : d1)];
        p0[r] = (colok && d0 >= 0 && d0 < W) ? fmaf(p0[r], C2, b0) : NEG_INF;
        p1[r] = (colok && d1 >= 0 && d1 < W) ? fmaf(p1[r], C2, b1) : NEG_INF;
    }
}
__device__ __forceinline__ float rowmax32(const f32x16& p0, const f32x16& p1) {
    float a = fmaxf(p0[0], p1[0]);
#pragma unroll
    for (int r = 1; r < 16; ++r) a = fmaxf(a, fmaxf(p0[r], p1[r]));
    return swapmax(a);
}
__device__ __forceinline__ void scale_rows(f32x16 (&o)[2], float f, LAS float* wsf, int r32, int hi) {
    if (hi == 0) wsf[r32] = f;
    asm volatile("s_waitcnt lgkmcnt(0)" ::: "memory");
#pragma unroll
    for (int g = 0; g < 4; ++g) { const f32x4_t fv = *(const LAS f32x4_t*)(wsf + 8 * g + 4 * hi);
#pragma unroll
        for (int i = 0; i < 4; ++i) { o[0][4 * g + i] *= fv[i]; o[1][4 * g + i] *= fv[i]; } }
    asm volatile("" : "+v"(o[0]), "+v"(o[1]));
    asm volatile("s_waitcnt lgkmcnt(0)" ::: "memory");
}
__device__ __forceinline__ void axpy_rows(unsigned (&accp)[2][8], const f32x16 (&o)[2], float f, LAS float* wsf, int r32, int hi) {
    if (hi == 0) wsf[r32] = f;
    asm volatile("s_waitcnt lgkmcnt(0)" ::: "memory");
#pragma unroll
    for (int g = 0; g < 4; ++g) { const f32x4_t fv = *(const LAS f32x4_t*)(wsf + 8 * g + 4 * hi);
#pragma unroll
        for (int d = 0; d < 2; ++d)
#pragma unroll
            for (int i = 0; i < 2; ++i) { const unsigned w = accp[d][2 * g + i];
                accp[d][2 * g + i] = cvtpk(fmaf(fv[2 * i], o[d][4 * g + 2 * i], QLO(w)), fmaf(fv[2 * i + 1], o[d][4 * g + 2 * i + 1], QHI(w))); asm volatile("" : "+v"(accp[d][2 * g + i])); } }
    asm volatile("s_waitcnt lgkmcnt(0)" ::: "memory");
}
__device__ __forceinline__ void osm_update(f32x16& p0, f32x16& p1, float& m, float& l, f32x16 (&o)[2], LAS float* wsf, int r32, int hi) {
    const float rm = rowmax32(p0, p1);
    if (__any(rm > m + THR)) {
        const float mn = fmaxf(m, rm), f = __builtin_amdgcn_exp2f(m - mn);
        l *= f; m = mn;
        scale_rows(o, f, wsf, r32, hi);
    }
    float s = 0.f;
#pragma unroll
    for (int r = 0; r < 16; ++r) { p0[r] = __builtin_amdgcn_exp2f(p0[r] - m); p1[r] = __builtin_amdgcn_exp2f(p1[r] - m); s += p0[r] + p1[r]; }
    l += s;
}
template <class RowOff>
__device__ __forceinline__ void store_cols(const f32x16 (&acc)[2], LAS unsigned char* stg, bf16_t* dst, const RowOff& ro, int lane, int r32, int hi) {
    LAS bf16_t* s = (LAS bf16_t*)stg;
#pragma unroll
    for (int r = 0; r < 16; ++r) { const int q = crow(r, hi); s[q * 64 + r32] = (bf16_t)f2bf(acc[0][r]); s[q * 64 + 32 + r32] = (bf16_t)f2bf(acc[1][r]); }
    asm volatile("s_waitcnt lgkmcnt(0)" ::: "memory");
#pragma unroll
    for (int i = 0; i < 4; ++i) { const int q = i * 8 + (lane >> 3), ch = lane & 7; const u32x4 v = *(const LAS u32x4*)(stg + q * 128 + ch * 16); *(u32x4*)(dst + ro(q) + ch * 8) = v; }
    asm volatile("s_waitcnt lgkmcnt(0)" ::: "memory");
}
struct RowOffNsa { size_t base; __device__ __forceinline__ size_t operator()(int q) const { return base + (size_t)(q >> 2) * DM + (q & 3) * 64; } };
struct RowOffTok { size_t base; __device__ __forceinline__ size_t operator()(int q) const { return base + (size_t)q * DM; } };

__device__ __forceinline__ void build_tabd(LAS unsigned char* lds, const float* __restrict__ rel, int tid) {
    LAS float* tabd = (LAS float*)(lds + L_TABD);
    for (int i = tid; i < 8 * 128; i += NTHR) tabd[i] = rel[(i >> 7) * 32 + rel_bucket(i & 127)] * LOG2E;
    __syncthreads();
}

#define ATT_TILE_LOOP(nt, Kp, Vp, PITCH, WITHV, ROW, COMPUTE) do { \
    if ((nt) > 0) { KVRegs R_; kv_load(R_, (Kp) + (size_t)(ROW(0)) * (PITCH), (Vp) + (size_t)(ROW(0)) * (PITCH), (PITCH), tid, (WITHV)); kv_store(R_, lds + L_KV, tid, (WITHV)); __syncthreads(); \
      for (int it = 0; it < (nt); ++it) { \
        LAS unsigned char* cur_ = lds + L_KV + (it & 1) * KVBUF; LAS unsigned char* nxt_ = lds + L_KV + ((it + 1) & 1) * KVBUF; \
        const bool more_ = it + 1 < (nt); \
        if (more_) kv_load(R_, (Kp) + (size_t)(ROW(it + 1)) * (PITCH), (Vp) + (size_t)(ROW(it + 1)) * (PITCH), (PITCH), tid, (WITHV)); \
        { COMPUTE(it, cur_); } \
        if (more_) kv_store(R_, nxt_, tid, (WITHV)); \
        __syncthreads(); } } } while (0)

__device__ __forceinline__ void nsa_block(LAS unsigned char* lds, const bf16_t* Hb, const bf16_t* KCb, const bf16_t* VCb, bf16_t* MIXb, int blk) {
    const int tid = fresh_tid(), lane = tid & 63, r32 = lane & 31, hi = lane >> 5, wid = __builtin_amdgcn_readfirstlane(tid >> 6);
    const int tl = r32 >> 2, h = r32 & 3, tokw = blk * 64 + wid * 8, t = tokw + tl;
    LAS float* wsf = (LAS float*)(lds + L_WSF) + wid * 64;
    const LAS float* tabdh = (const LAS float*)(lds + L_TABD) + h * 128;
    LAS float* imp = (LAS float*)(lds + L_IMP);
    LAS unsigned* selb = (LAS unsigned*)(lds + L_SEL);
    const float tabc = tabdh[127];
    const bf16_t* hrow = Hb + (size_t)t * HP;
    bf16x8 qr[4];
#pragma unroll
    for (int d0 = 0; d0 < 4; ++d0) qr[d0] = *(const bf16x8*)(hrow + LayB::QN + h * 64 + d0 * 16 + hi * 8);
    const float g0 = sigmoidf_(bf2f(hrow[LayB::GN + h * 3 + 0])), g1 = sigmoidf_(bf2f(hrow[LayB::GN + h * 3 + 1])), g2 = sigmoidf_(bf2f(hrow[LayB::GN + h * 3 + 2]));
    for (int i = tid; i < 64 * 129; i += NTHR) imp[i] = 0.f;
    if (tid < 256) selb[tid] = 0u;
    const f32x16 z16 = {0.f, 0.f, 0.f, 0.f, 0.f, 0.f, 0.f, 0.f, 0.f, 0.f, 0.f, 0.f, 0.f, 0.f, 0.f, 0.f};
    unsigned accp[2][8]; f32x16 o[2];
#pragma unroll
    for (int i = 0; i < 8; ++i) { accp[0][i] = 0u; accp[1][i] = 0u; }
    float m, l;
    __syncthreads();

    const int tmax = blk * 64 + 63, cntmax = tmax >= 31 ? (tmax - 31) / 16 + 1 : 0, ntc = (cntmax + 63) >> 6;
    const int Dc = t - 31;
    const int twmin = tokw;
#define ROWC(i) ((i) * 64)
    m = M_INIT; l = 0.f;
#define CMP1(it, kv) do { f32x16 p0, p1; qk_tile(p0, p1, kv, qr, r32, hi); const int n0 = (it) * 64; \
        if (twmin - 31 - 16 * (n0 + 63) >= 128) bias_far(p0, p1, tabc); else bias_near<16, (1 << 30)>(p0, p1, Dc - 16 * n0, tabdh, true, hi); \
        const float rm = rowmax32(p0, p1), mn = fmaxf(m, rm); l *= __builtin_amdgcn_exp2f(m - mn); m = mn; float s_ = 0.f; \
        _Pragma("unroll") for (int r = 0; r < 16; ++r) s_ += __builtin_amdgcn_exp2f(p0[r] - m) + __builtin_amdgcn_exp2f(p1[r] - m); l += s_; } while (0)
    ATT_TILE_LOOP(ntc, KCb, VCb, 64, false, ROWC, CMP1);
    {
        const float lt = swapsum(l), inv = lt > 0.f ? 1.0f / lt : 0.f;
        o[0] = z16; o[1] = z16;
#define CMP2(it, kv) do { f32x16 p0, p1; qk_tile(p0, p1, kv, qr, r32, hi); const int n0 = (it) * 64; \
        if (twmin - 31 - 16 * (n0 + 63) >= 128) bias_far(p0, p1, tabc); else bias_near<16, (1 << 30)>(p0, p1, Dc - 16 * n0, tabdh, true, hi); \
        _Pragma("unroll") for (int r = 0; r < 16; ++r) { p0[r] = __builtin_amdgcn_exp2f(p0[r] - m) * inv; p1[r] = __builtin_amdgcn_exp2f(p1[r] - m) * inv; } \
        _Pragma("unroll") for (int g = 0; g < 4; ++g) { \
            float a0 = (p0[4 * g] + p0[4 * g + 1]) + (p0[4 * g + 2] + 0.5f * p0[4 * g + 3]), b0 = 0.5f * p0[4 * g + 3]; \
            float a1 = (p1[4 * g] + p1[4 * g + 1]) + (p1[4 * g + 2] + 0.5f * p1[4 * g + 3]), b1 = 0.5f * p1[4 * g + 3]; \
            a0 += __shfl_xor(a0, 1); b0 += __shfl_xor(b0, 1); a1 += __shfl_xor(a1, 1); b1 += __shfl_xor(b1, 1); \
            a0 += __shfl_xor(a0, 2); b0 += __shfl_xor(b0, 2); a1 += __shfl_xor(a1, 2); b1 += __shfl_xor(b1, 2); \
            if (h == 0) { const int j0 = (n0 >> 2) + 2 * g + hi; float* ip = (float*)(imp + (wid * 8 + tl) * 129 + j0); \
                atomicAdd(ip, a0); atomicAdd(ip + 1, b0); atomicAdd(ip + 8, a1); atomicAdd(ip + 9, b1); } } \
        pv_tile(o, kv + 8192, p0, p1, lane, hi); } while (0)
        ATT_TILE_LOOP(ntc, KCb, VCb, 64, true, ROWC, CMP2);
        axpy_rows(accp, o, g0, wsf, r32, hi);
    }
    __syncthreads();
    {
        const int tok = tid >> 3, part = tid & 7;
        const LAS float* ir = imp + tok * 129;
        unsigned bits = 0u;
        for (int jj = 0; jj < 16; ++jj) {
            const int j = part * 16 + jj;
            const bool fj = (j == 0) || (j == blk) || (j == blk - 1);
            const float vj = fj ? BIGF : (j <= blk ? ir[j] : -BIGF);
            int rank = 0;
            for (int i = 0; i < 128; ++i) {
                const bool fi = (i == 0) || (i == blk) || (i == blk - 1);
                const float vi = fi ? BIGF : (i <= blk ? ir[i] : -BIGF);
                rank += (vi > vj || (vi == vj && i < j)) ? 1 : 0;
            }
            if (rank < 16 && j <= blk) bits |= 1u << jj;
        }
        atomicOr((unsigned*)(selb + tok * 4 + (part >> 1)), bits << ((part & 1) * 16));
    }
    __syncthreads();
    unsigned sm[4];
#pragma unroll
    for (int i = 0; i < 4; ++i) sm[i] = selb[(wid * 8 + tl) * 4 + i];
    const int Ds = t;
    m = M_INIT; l = 0.f; o[0] = z16; o[1] = z16;
#define ROWS(i) ((i) * 64)
#define SELT(it, kv) do { const int j = (it); const unsigned w_ = j < 32 ? sm[0] : (j < 64 ? sm[1] : (j < 96 ? sm[2] : sm[3])); const bool bit = (w_ >> (j & 31)) & 1u; \
        if (__any(bit)) { f32x16 p0, p1; qk_tile(p0, p1, kv, qr, r32, hi); \
            if (twmin - (j * 64 + 63) >= 128) bias_far(p0, p1, bit ? tabc : NEG_INF); else bias_near<1, (1 << 30)>(p0, p1, Ds - j * 64, tabdh, bit, hi); \
            osm_update(p0, p1, m, l, o, wsf, r32, hi); pv_tile(o, kv + 8192, p0, p1, lane, hi); } } while (0)
    ATT_TILE_LOOP(blk + 1, Hb + LayB::KS, Hb + LayB::VS, HP, true, ROWS, SELT);
    { const float lt = swapsum(l), inv = lt > 0.f ? 1.0f / lt : 0.f; axpy_rows(accp, o, g1 * inv, wsf, r32, hi); }
    const int jw0 = blk >= 8 ? blk - 8 : 0;
    m = M_INIT; l = 0.f; o[0] = z16; o[1] = z16;
#define ROWW(i) ((jw0 + (i)) * 64)
#define WINT(it, kv) do { const int j = jw0 + (it); f32x16 p0, p1; qk_tile(p0, p1, kv, qr, r32, hi); \
        if (twmin - (j * 64 + 63) >= 128 && (tokw + 7) - j * 64 < 512) bias_far(p0, p1, tabc); else bias_near<1, 512>(p0, p1, Ds - j * 64, tabdh, true, hi); \
        osm_update(p0, p1, m, l, o, wsf, r32, hi); pv_tile(o, kv + 8192, p0, p1, lane, hi); } while (0)
    ATT_TILE_LOOP(blk - jw0 + 1, Hb + LayB::KW, Hb + LayB::VW, HP, true, ROWW, WINT);
    { const float lt = swapsum(l), inv = lt > 0.f ? 1.0f / lt : 0.f; axpy_rows(accp, o, g2 * inv, wsf, r32, hi); }
    {
#pragma unroll
        for (int d = 0; d < 2; ++d)
#pragma unroll
            for (int i = 0; i < 8; ++i) { o[d][2 * i] = QLO(accp[d][i]); o[d][2 * i + 1] = QHI(accp[d][i]); }
        const RowOffNsa ro{(size_t)tokw * DM}; store_cols(o, lds + L_OST + wid * 4096, MIXb, ro, lane, r32, hi); }
    __syncthreads();
#undef ROWC
#undef CMP1
#undef CMP2
#undef ROWS
#undef SELT
#undef ROWW
#undef WINT
}

__device__ __forceinline__ void moba_block(LAS unsigned char* lds, const bf16_t* Hb, const float* __restrict__ KMh, bf16_t* MIXb, int hd, int own) {
    const int tid = fresh_tid(), lane = tid & 63, r32 = lane & 31, hi = lane >> 5, wid = __builtin_amdgcn_readfirstlane(tid >> 6);
    LAS float* wsf = (LAS float*)(lds + L_WSF) + wid * 64;
    const LAS float* tabdh = (const LAS float*)(lds + L_TABD) + (4 + hd) * 128;
    LAS float* kml = (LAS float*)(lds + L_IMP);
    LAS unsigned* selb = (LAS unsigned*)(lds + L_SEL);
    const float tabc = tabdh[127];
    for (int i = tid; i < 32 * 64; i += NTHR) kml[i] = KMh[i];
    __syncthreads();
    if (tid < 256) {
        const int tg = own * 256 + tid;
        unsigned q[32];
        load_qp(q, Hb + (size_t)tg * HP + LayB::QM + hd * 64);
        float v0 = -BIGF, v1 = -BIGF, v2 = -BIGF; int i0 = -1, i1 = -1, i2 = -1;
        for (int j = 0; j < own; ++j) {
            const LAS float* kr = kml + j * 64; float s0 = 0.f, s1 = 0.f;
#pragma unroll
            for (int c = 0; c < 16; ++c) { const f32x4_t w = *(const LAS f32x4_t*)(kr + 4 * c);
                s0 = fmaf(QLO(q[2 * c]), w[0], s0); s1 = fmaf(QHI(q[2 * c]), w[1], s1); s0 = fmaf(QLO(q[2 * c + 1]), w[2], s0); s1 = fmaf(QHI(q[2 * c + 1]), w[3], s1); }
            const float g = s0 + s1;
            if (g > v0) { v2 = v1; i2 = i1; v1 = v0; i1 = i0; v0 = g; i0 = j; }
            else if (g > v1) { v2 = v1; i2 = i1; v1 = g; i1 = j; }
            else if (g > v2) { v2 = g; i2 = j; }
        }
        unsigned mk = 0u;
        if (i0 >= 0) mk |= 1u << i0;
        if (i1 >= 0) mk |= 1u << i1;
        if (i2 >= 0) mk |= 1u << i2;
        selb[tid] = mk;
    }
    __syncthreads();
    const int tokw = own * 256 + wid * 32, t = tokw + r32;
    const unsigned mk = selb[wid * 32 + r32];
    bf16x8 qr[4];
#pragma unroll
    for (int d0 = 0; d0 < 4; ++d0) qr[d0] = *(const bf16x8*)(Hb + (size_t)t * HP + LayB::QM + hd * 64 + d0 * 16 + hi * 8);
    const f32x16 z16 = {0.f, 0.f, 0.f, 0.f, 0.f, 0.f, 0.f, 0.f, 0.f, 0.f, 0.f, 0.f, 0.f, 0.f, 0.f, 0.f};
    f32x16 o[2] = {z16, z16};
    float m = M_INIT, l = 0.f;
    const int nt = own * 4 + 4;
#define ROWM(i) ((i) * 64)
#define MOBT(it, kv) do { const int pos0 = (it) * 64; const bool past = (it) < own * 4; const bool bit = past ? ((mk >> ((it) >> 2)) & 1u) : true; \
        const bool need = past ? __any(bit) : (pos0 <= tokw + 31); \
        if (need) { f32x16 p0, p1; qk_tile(p0, p1, kv, qr, r32, hi); \
            if (tokw - (pos0 + 63) >= 128) bias_far(p0, p1, bit ? tabc : NEG_INF); else bias_near<1, (1 << 30)>(p0, p1, t - pos0, tabdh, bit, hi); \
            osm_update(p0, p1, m, l, o, wsf, r32, hi); pv_tile(o, kv + 8192, p0, p1, lane, hi); } } while (0)
    ATT_TILE_LOOP(nt, Hb + LayB::KM + hd * 64, Hb + LayB::VM + hd * 64, HP, true, ROWM, MOBT);
    { const float lt = swapsum(l), inv = lt > 0.f ? 1.0f / lt : 0.f; scale_rows(o, inv, wsf, r32, hi); }
    { const RowOffTok ro{(size_t)tokw * DM + 256 + hd * 64}; store_cols(o, lds + L_OST + wid * 4096, MIXb, ro, lane, r32, hi); }
    __syncthreads();
#undef ROWM
#undef MOBT
}
}

template <class L>
__device__ __forceinline__ void cmp_unit(LAS unsigned char* lds, const bf16_t* __restrict__ H, const float* __restrict__ pe, const bf16_t* __restrict__ W1T, const float* __restrict__ b1,
                                         const float* __restrict__ w2, bf16_t* KCV, int unit) {
    typedef short bf16x8v __attribute__((ext_vector_type(8)));
    typedef float f32x16v __attribute__((ext_vector_type(16)));
    const int tid = fresh_tid(), lane = tid & 63, r32 = lane & 31, hi = lane >> 5, wv = __builtin_amdgcn_readfirstlane(tid >> 6);
    const int which = unit >> 6, b = (unit >> 4) & 3, n0 = (unit & 15) * 32;
    LAS float* hid = (LAS float*)lds;
    for (int i = tid; i < 256 * 32; i += NTHR) hid[i] = 0.f;
    __syncthreads();
    {
        const int n = n0 + r32 < NCMP ? n0 + r32 : NCMP - 1;
        const bf16_t* krow = H + (size_t)(b * S_ + n * 16) * L::P + L::KC + which * 64;
        const float* pew = pe + which * 2048;
        const bf16_t* wrow = W1T + (size_t)which * 256 * 2048 + (size_t)r32 * 2048;
        const f32x16v z = {0.f, 0.f, 0.f, 0.f, 0.f, 0.f, 0.f, 0.f, 0.f, 0.f, 0.f, 0.f, 0.f, 0.f, 0.f, 0.f};
        f32x16v acc[8] = {z, z, z, z, z, z, z, z};
#pragma unroll 2
        for (int ks = 0; ks < 16; ++ks) {
            const int p = wv * 4 + (ks >> 2), dc = ks & 3, kk = p * 64 + dc * 16 + hi * 8;
            const uint4 kraw = *(const uint4*)(krow + (size_t)p * L::P + dc * 16 + hi * 8);
            const float4 pa = *(const float4*)(pew + kk), pb = *(const float4*)(pew + kk + 4);
            typedef unsigned u32x4v __attribute__((ext_vector_type(4)));
            const u32x4v bw = {pk2(QLO(kraw.x) + pa.x, QHI(kraw.x) + pa.y), pk2(QLO(kraw.y) + pa.z, QHI(kraw.y) + pa.w), pk2(QLO(kraw.z) + pb.x, QHI(kraw.z) + pb.y), pk2(QLO(kraw.w) + pb.z, QHI(kraw.w) + pb.w)};
            const bf16x8v bf = __builtin_bit_cast(bf16x8v, bw);
#pragma unroll
            for (int jt = 0; jt < 8; ++jt) { const bf16x8v af = *(const bf16x8v*)(wrow + (size_t)jt * 32 * 2048 + kk); acc[jt] = __builtin_amdgcn_mfma_f32_32x32x16_bf16(af, bf, acc[jt], 0, 0, 0); }
        }
#pragma unroll
        for (int jt = 0; jt < 8; ++jt)
#pragma unroll
            for (int r = 0; r < 16; ++r) atomicAdd((float*)(hid + (jt * 32 + (r & 3) + 8 * (r >> 2) + 4 * hi) * 32 + r32), acc[jt][r]);
    }
    __syncthreads();
    for (int i = tid; i < 256 * 32; i += NTHR) { const float a = hid[i] + b1[which * 256 + (i >> 5)]; hid[i] = 0.5f * a * (1.0f + tanhf(0.7978845608028654f * (a + 0.044715f * a * a * a))); }
    __syncthreads();
    {
        const int d = tid & 63, ng = tid >> 6;
        float o[4] = {0.f, 0.f, 0.f, 0.f};
        const float* w2p = w2 + (size_t)which * 256 * 64 + d;
#pragma unroll 8
        for (int j = 0; j < 256; ++j) { const float wj = w2p[j * 64]; const f32x4_t hv = *(const LAS f32x4_t*)(hid + j * 32 + ng * 4);
#pragma unroll
            for (int r = 0; r < 4; ++r) o[r] = fmaf(hv[r], wj, o[r]); }
#pragma unroll
        for (int r = 0; r < 4; ++r) { const int n = n0 + ng * 4 + r; KCV[(((size_t)which * B_ + b) * 512 + n) * 64 + d] = (bf16_t)f2bf(n < NCMP ? o[r] : 0.f); }
    }
    __syncthreads();
}
template <class L>
__device__ __forceinline__ void kmean_unit(LAS unsigned char* lds, const typename L::T* H, float* KM, int unit) {
    const int tid = fresh_tid(), b = unit >> 7, h = (unit >> 5) & 3, j = unit & 31, d = tid & 63, g = tid >> 6;
    LAS float* part = (LAS float*)lds;
    const typename L::T* src = H + (size_t)(b * S_ + j * 256) * L::P + L::KM + h * 64 + d;
    float s = 0.f;
    for (int r = g; r < 256; r += 8) s += ldf(src + (size_t)r * L::P);
    part[g * 64 + d] = s;
    __syncthreads();
    if (tid < 64) { float t = 0.f;
#pragma unroll
        for (int gg = 0; gg < 8; ++gg) t += part[gg * 64 + tid];
        KM[((size_t)(b * 4 + h) * 32 + j) * 64 + tid] = t * (1.0f / 256.0f); }
    __syncthreads();
}
template <class L>
__device__ __forceinline__ void conv_unit(LAS unsigned char* lds, const bf16_t* __restrict__ H, const float* __restrict__ wdw, const float* __restrict__ bdw, const float* __restrict__ lng,
                                          const float* __restrict__ lnb, const bf16_t* __restrict__ WPT, bf16_t* __restrict__ MIX, int unit) {
    typedef short bf16x8v __attribute__((ext_vector_type(8)));
    typedef float f32x16v __attribute__((ext_vector_type(16)));
    const int tid = fresh_tid(), g0 = unit * 64, tb = g0 & (S_ - 1);
    LAS bf16_t* HsB = (LAS bf16_t*)lds;
    LAS float* Ys = (LAS float*)(lds + 49152);
    LAS unsigned char* Ab = lds;
    for (int q = tid; q < 94 * 32; q += NTHR) {
        const int r = q >> 5, c8 = q & 31, dt = r - 30;
        typedef unsigned u32x4v __attribute__((ext_vector_type(4)));
        u32x4v o = {0u, 0u, 0u, 0u};
        if (tb + dt >= 0) {
            const bf16_t* hr = H + (size_t)(g0 + dt) * L::P + L::CV + c8 * 8;
            const uint4 a = *(const uint4*)hr, g = *(const uint4*)(hr + 256);
            const unsigned av[4] = {a.x, a.y, a.z, a.w}, gv[4] = {g.x, g.y, g.z, g.w}; unsigned ov[4];
#pragma unroll
            for (int i = 0; i < 4; ++i) ov[i] = pk2(QLO(av[i]) * sigmoidf_(QLO(gv[i])), QHI(av[i]) * sigmoidf_(QHI(gv[i])));
            o = (u32x4v){ov[0], ov[1], ov[2], ov[3]};
        }
        *(LAS u32x4v*)(HsB + r * 256 + c8 * 8) = o;
    }
    __syncthreads();
    {
        const int cp = tid & 127, tg = tid >> 7;
        float w0[31], w1[31];
#pragma unroll
        for (int k = 0; k < 31; ++k) { const float2 wv = *(const float2*)(wdw + k * 256 + 2 * cp); w0[k] = wv.x; w1[k] = wv.y; }
        const float2 bb = *(const float2*)(bdw + 2 * cp);
        float a0[16], a1[16];
#pragma unroll
        for (int i = 0; i < 16; ++i) { a0[i] = bb.x; a1[i] = bb.y; }
#pragma unroll
        for (int rr = 0; rr < 46; ++rr) {
            const unsigned hv = *(const LAS unsigned*)(HsB + (16 * tg + rr) * 256 + 2 * cp);
            const float h0 = QLO(hv), h1 = QHI(hv);
#pragma unroll
            for (int i = 0; i < 16; ++i) { const int k = rr - i; if (k >= 0 && k <= 30) { a0[i] = fmaf(h0, w0[k], a0[i]); a1[i] = fmaf(h1, w1[k], a1[i]); } }
        }
#pragma unroll
        for (int i = 0; i < 16; ++i) { typedef float f32x2v __attribute__((ext_vector_type(2))); *(LAS f32x2v*)(Ys + (16 * tg + i) * 256 + 2 * cp) = (f32x2v){a0[i], a1[i]}; }
    }
    __syncthreads();
    {
        const int wv = __builtin_amdgcn_readfirstlane(tid >> 6), lane = tid & 63;
        const f32x4_t gg = *(const f32x4_t*)(lng + 4 * lane), bt = *(const f32x4_t*)(lnb + 4 * lane);
#pragma unroll
        for (int i = 0; i < 8; ++i) {
            const int tk = wv * 8 + i;
            f32x4_t v = *(const LAS f32x4_t*)(Ys + tk * 256 + 4 * lane);
            float s = (v[0] + v[1]) + (v[2] + v[3]);
#pragma unroll
            for (int o = 1; o < 64; o <<= 1) s += __shfl_xor(s, o);
            const float mu = s * (1.0f / 256.0f);
            v = v - mu;
            float s2 = (v[0] * v[0] + v[1] * v[1]) + (v[2] * v[2] + v[3] * v[3]);
#pragma unroll
            for (int o = 1; o < 64; o <<= 1) s2 += __shfl_xor(s2, o);
            const float rstd = 1.0f / sqrtf(s2 * (1.0f / 256.0f) + 1e-5f);
            f32x4_t y = v * rstd * gg + bt;
#pragma unroll
            for (int e = 0; e < 4; ++e) y[e] = y[e] * sigmoidf_(y[e]);
            typedef unsigned u32x2v __attribute__((ext_vector_type(2)));
            *(LAS u32x2v*)(Ab + tk * 512 + (((lane >> 1) ^ (tk & 31)) * 16) + (lane & 1) * 8) = (u32x2v){pk2(y[0], y[1]), pk2(y[2], y[3])};
        }
    }
    __syncthreads();
    {
        const int wv = __builtin_amdgcn_readfirstlane(tid >> 6), lane = tid & 63, r32 = lane & 31, hi = lane >> 5, n0 = wv * 32;
        bf16x8v af[16];
#pragma unroll
        for (int ks = 0; ks < 16; ++ks) af[ks] = *(const bf16x8v*)(WPT + (size_t)(n0 + r32) * 256 + ks * 16 + hi * 8);
        const f32x16v z = {0.f, 0.f, 0.f, 0.f, 0.f, 0.f, 0.f, 0.f, 0.f, 0.f, 0.f, 0.f, 0.f, 0.f, 0.f, 0.f};
        f32x16v c0 = z, c1 = z;
#pragma unroll
        for (int ks = 0; ks < 16; ++ks) {
            const int ph = ((2 * ks + hi) ^ r32) * 16;
            const bf16x8v b0 = *(const LAS bf16x8v*)(Ab + r32 * 512 + ph), b1 = *(const LAS bf16x8v*)(Ab + (32 + r32) * 512 + ph);
            c0 = __builtin_amdgcn_mfma_f32_32x32x16_bf16(af[ks], b0, c0, 0, 0, 0);
            c1 = __builtin_amdgcn_mfma_f32_32x32x16_bf16(af[ks], b1, c1, 0, 0, 0);
        }
        typedef unsigned u32x2v __attribute__((ext_vector_type(2)));
#pragma unroll
        for (int g = 0; g < 4; ++g) {
            bf16_t* d0 = MIX + (size_t)(g0 + r32) * DM + 512 + n0 + 8 * g + 4 * hi;
            *(u32x2v*)d0 = (u32x2v){pk2(c0[4 * g], c0[4 * g + 1]), pk2(c0[4 * g + 2], c0[4 * g + 3])};
            *(u32x2v*)(d0 + (size_t)32 * DM) = (u32x2v){pk2(c1[4 * g], c1[4 * g + 1]), pk2(c1[4 * g + 2], c1[4 * g + 3])};
        }
    }
    __syncthreads();
}
template <class L>
__device__ __forceinline__ void hgrn1_unit(LAS unsigned char* lds, const typename L::T* H, const float* __restrict__ lb, float* OL, float* QP, float* U, float* Dg, int unit) {
    const int tid = fresh_tid(), v = tid & 63, kg = tid >> 6, k0 = kg * 8, b = unit >> 6, h = (unit >> 4) & 3, seg = unit & 15;
    LAS float* Fl = (LAS float*)lds; LAS float* Ql = Fl + HT * 64; LAS float* Vl = Ql + HT * 64; LAS float* QPl = Vl + HT * 64; LAS float* Op = QPl + HT * 64;
    float s[8];
#pragma unroll
    for (int i = 0; i < 8; ++i) s[i] = 0.f;
    float P = 1.0f;
    for (int c = 0; c < HSEG / HT; ++c) {
        const size_t tb = (size_t)b * S_ + seg * HSEG + c * HT;
        for (int idx = tid; idx < HT * 64; idx += NTHR) {
            const int tt = idx >> 6, cc = idx & 63; const typename L::T* hr = H + (tb + tt) * L::P;
            const float lbv = lb[h * 64 + cc];
            Fl[idx] = lbv + (1.0f - lbv) * sigmoidf_(ldf(hr + L::FH + h * 64 + cc));
            Ql[idx] = ldf(hr + L::QH + h * 64 + cc);
            Vl[idx] = ldf(hr + L::IH + h * 64 + cc);
        }
        __syncthreads();
        if (tid < 64) { for (int tt = 0; tt < HT; ++tt) { P *= Fl[tt * 64 + tid]; QPl[tt * 64 + tid] = Ql[tt * 64 + tid] * P; } }
        for (int tt = 0; tt < HT; ++tt) {
            const float vv = Vl[tt * 64 + v];
            const f32x4_t fa = *(const LAS f32x4_t*)&Fl[tt * 64 + k0], fb = *(const LAS f32x4_t*)&Fl[tt * 64 + k0 + 4];
            const f32x4_t qa = *(const LAS f32x4_t*)&Ql[tt * 64 + k0], qb = *(const LAS f32x4_t*)&Ql[tt * 64 + k0 + 4];
            const float f[8] = {fa.x, fa.y, fa.z, fa.w, fb.x, fb.y, fb.z, fb.w}, q[8] = {qa.x, qa.y, qa.z, qa.w, qb.x, qb.y, qb.z, qb.w};
            float o0 = 0.f, o1 = 0.f;
#pragma unroll
            for (int i = 0; i < 8; i += 2) {
                s[i] = fmaf(f[i], s[i], (1.0f - f[i]) * vv); o0 = fmaf(q[i], s[i], o0);
                s[i + 1] = fmaf(f[i + 1], s[i + 1], (1.0f - f[i + 1]) * vv); o1 = fmaf(q[i + 1], s[i + 1], o1);
            }
            Op[(kg * HT + tt) * 64 + v] = o0 + o1;
        }
        __syncthreads();
        for (int idx = tid; idx < HT * 64; idx += NTHR) {
            const int tt = idx >> 6, cc = idx & 63;
            float o = 0.f;
#pragma unroll
            for (int g = 0; g < 8; ++g) o += Op[(g * HT + tt) * 64 + cc];
            OL[(tb + tt) * 256 + h * 64 + cc] = o;
            QP[(tb + tt) * 256 + h * 64 + cc] = QPl[idx];
        }
        __syncthreads();
    }
    float* Uu = U + (size_t)unit * 4096;
#pragma unroll
    for (int i = 0; i < 8; ++i) Uu[(k0 + i) * 64 + v] = s[i];
    if (tid < 64) Dg[unit * 64 + tid] = P;
}
template <class L>
__device__ __forceinline__ void hgrn2_unit(const typename L::T* H, const float* __restrict__ OL, const float* __restrict__ QP, const float* __restrict__ U, const float* __restrict__ Dg,
                                           const float* __restrict__ ng, bf16_t* __restrict__ MIX, int unit) {
    const int tid = fresh_tid(), v = tid & 63, wv = tid >> 6, b = unit >> 6, h = (unit >> 4) & 3, seg = unit & 15;
    float Sr[64];
#pragma unroll
    for (int k = 0; k < 64; ++k) Sr[k] = 0.f;
    for (int j = 0; j < seg; ++j) {
        const float* Uu = U + (size_t)(unit - seg + j) * 4096; const float* Dd = Dg + (unit - seg + j) * 64;
#pragma unroll
        for (int k = 0; k < 64; ++k) Sr[k] = fmaf(Dd[k], Sr[k], Uu[k * 64 + v]);
    }
    const float gn = ng[h * 64 + v];
#pragma unroll 4
    for (int i = 0; i < HSEG / 8; ++i) {
        const size_t t = (size_t)b * S_ + seg * HSEG + i * 8 + wv;
        const float* qp = QP + t * 256 + h * 64;
        float o = OL[t * 256 + h * 64 + v];
#pragma unroll
        for (int k = 0; k < 64; k += 4) { const float4 qv = *(const float4*)(qp + k); o = fmaf(qv.x, Sr[k], o); o = fmaf(qv.y, Sr[k + 1], o); o = fmaf(qv.z, Sr[k + 2], o); o = fmaf(qv.w, Sr[k + 3], o); }
        float ss = o * o;
#pragma unroll
        for (int d = 1; d < 64; d <<= 1) ss += __shfl_xor(ss, d);
        const float r = 1.0f / sqrtf(ss * (1.0f / 64.0f) + 1e-6f);
        const float g = ldf(H + t * L::P + L::GH + h * 64 + v);
        MIX[t * DM + 768 + h * 64 + v] = (bf16_t)f2bf(o * r * gn * sigmoidf_(g));
    }
}
struct Frame {
    LAS unsigned char* lds; volatile LAS unsigned* MISC; unsigned* ctl;
    int tid, lane, wave, vcu, G;
};
__device__ __forceinline__ void transpose_item(const float* __restrict__ W, int K, int N, bf16_t* WT, LAS float* scr, int item, int lane, int shift_at, int shift) {
    const int nblk = (N + 31) / 32, kb = item / nblk, nb = item % nblk, k0 = 64 * kb, n0 = 32 * nb;
    const int nl = n0 + (lane & 31);
#pragma unroll 8
    for (int i = 0; i < 32; ++i) { const int kk = 2 * i + (lane >> 5); scr[kk * 33 + (lane & 31)] = nl < N ? W[(size_t)(k0 + kk) * N + nl] : 0.f; }
    asm volatile("s_waitcnt lgkmcnt(0)" ::: "memory");
    const int c = lane & 7;
#pragma unroll
    for (int j = 0; j < 4; ++j) { const int n = (lane >> 3) + 8 * j; const LAS float* s = scr + (8 * c) * 33 + n; const int ng = n0 + n;
        if (ng < N) { uint4 o; o.x = pk2(s[0 * 33], s[1 * 33]); o.y = pk2(s[2 * 33], s[3 * 33]); o.z = pk2(s[4 * 33], s[5 * 33]); o.w = pk2(s[6 * 33], s[7 * 33]);
            *(uint4*)(WT + (size_t)(ng + (ng >= shift_at ? shift : 0)) * K + k0 + 8 * c) = o; } }
    asm volatile("s_waitcnt lgkmcnt(0)" ::: "memory");
}
__device__ __forceinline__ void ln_row(const float* xrow, const float* __restrict__ g, const float* __restrict__ bta, float* orow, bf16_t* brow, int lane) {
    typedef float f32x4 __attribute__((ext_vector_type(4)));
    const f32x4* xr = (const f32x4*)xrow + lane;
    f32x4 v[4]; float s = 0.f;
#pragma unroll
    for (int j = 0; j < 4; ++j) { v[j] = xr[64 * j]; s += (v[j].x + v[j].y) + (v[j].z + v[j].w); }
#pragma unroll
    for (int o = 1; o < 64; o <<= 1) s += __shfl_xor(s, o);
    const float mean = s * (1.f / DM); float s2 = 0.f;
#pragma unroll
    for (int j = 0; j < 4; ++j) { v[j] = v[j] - mean; s2 += (v[j].x * v[j].x + v[j].y * v[j].y) + (v[j].z * v[j].z + v[j].w * v[j].w); }
#pragma unroll
    for (int o = 1; o < 64; o <<= 1) s2 += __shfl_xor(s2, o);
    const float rstd = 1.f / sqrtf(s2 * (1.f / DM) + 1e-5f);
#pragma unroll
    for (int j = 0; j < 4; ++j) { const f32x4 gg = ((const f32x4*)g)[lane + 64 * j], bb = ((const f32x4*)bta)[lane + 64 * j];
        const f32x4 y = v[j] * rstd * gg + bb;
        ((f32x4*)orow)[lane + 64 * j] = y;
        ((unsigned long long*)brow)[lane + 64 * j] = (unsigned long long)pk2(y.x, y.y) | ((unsigned long long)pk2(y.z, y.w) << 32); }
}

struct Args { const float* in[21]; float* out; unsigned char* ws; int ph_lo, ph_hi; };
constexpr int NPHASE = 1 + 8 * DEPTH;

__global__ void __launch_bounds__(NTHR, 2) mega_fwd(Args args) {
    extern __shared__ __attribute__((aligned(16))) unsigned char lds_raw[];
    Frame F;
    F.lds = (LAS unsigned char*)lds_raw;
    F.MISC = (volatile LAS unsigned*)(F.lds + MISC_OFF);
    F.tid = threadIdx.x; F.lane = F.tid & 63; F.wave = __builtin_amdgcn_readfirstlane(F.tid >> 6);
    F.G = gridDim.x; { const int bx = blockIdx.x; F.vcu = (F.G % 8 == 0) ? (bx % 8) * (F.G / 8) + bx / 8 : bx; }
    unsigned char* ws = args.ws;
    F.ctl = (unsigned*)(ws + WS_CTL);
    const float* x = args.in[0];       const float* w_in = args.in[1];
    const float* cmp_pe = args.in[2];  const float* cmp_w1 = args.in[3];  const float* cmp_b1 = args.in[4];  const float* cmp_w2 = args.in[5];
    const float* dw_w = args.in[6];    const float* dw_b = args.in[7];    const float* cln_g = args.in[8];   const float* cln_b = args.in[9];
    const float* pw_w = args.in[10];   const float* lb_logits = args.in[11]; const float* hn_g = args.in[12]; const float* w_out = args.in[13];
    const float* ln1_g = args.in[14];  const float* ln1_b = args.in[15];  const float* w_ff1 = args.in[16];  const float* w_ff2 = args.in[17];
    const float* ln2_g = args.in[18];  const float* ln2_b = args.in[19];  const float* rel = args.in[20];
    float* out = args.out;
    bf16_t* WIN = (bf16_t*)(ws + WS_WIN); bf16_t* WOUT = (bf16_t*)(ws + WS_WOUT); bf16_t* W1 = (bf16_t*)(ws + WS_W1); bf16_t* W2 = (bf16_t*)(ws + WS_W2);
    bf16_t* XB = (bf16_t*)(ws + WS_XB); bf16_t* HB = (bf16_t*)(ws + WS_H); bf16_t* MIX = (bf16_t*)(ws + WS_MIX); bf16_t* HFF = (bf16_t*)(ws + WS_HFF);
    bf16_t* KCV = (bf16_t*)(ws + WS_KCV); float* KM = (float*)(ws + WS_KM); float* OL = (float*)(ws + WS_OL); float* QP = (float*)(ws + WS_QP);
    float* U = (float*)(ws + WS_U); float* Dg = (float*)(ws + WS_DG); float* LBS = (float*)(ws + WS_LBS); bf16_t* WPT = (bf16_t*)(ws + WS_WPT); bf16_t* W1CT = (bf16_t*)(ws + WS_W1CT);

    for (int u = F.tid; u < (LDS_BYTES - LDSCTL_OFF) / 4; u += NTHR) ((LAS unsigned*)(F.lds + LDSCTL_OFF))[u] = 0u;
    __syncthreads();
    XcdBarrier bar = xcd_barrier_post((unsigned*)(F.ctl + CW_BAR), F.MISC + 8);
    const int lo = args.ph_lo, hi = args.ph_hi;
#define IN(k) (lo <= (k) && (k) < hi)
#define SEAM(k) do { if (IN(k) && IN((k) + 1)) xcd_barrier(bar); } while (0)

    if (IN(0)) {
#ifdef REP_PRO
        for (int rep_ = 0; rep_ < 2; ++rep_) {
#endif
        const int tid = fresh_tid(), lane = tid & 63, wave = __builtin_amdgcn_readfirstlane(tid >> 6);
        LAS float* scr = (LAS float*)(F.lds + wave * 16384);
        const int gw = F.vcu * NWAVES + wave, NGW = F.G * NWAVES;
        constexpr int I_IN = 16 * 93, I_OUT = 16 * 32, I_1 = 16 * 128, I_2 = 64 * 32, I_PW = 4 * 8, I_C1 = 2 * 256;
        constexpr int NITEMS = DEPTH * (I_IN + I_OUT + I_1 + I_2 + I_PW + I_C1);
        for (int it = gw; it < NITEMS; it += NGW) {
            int r = it; const int l = r / (I_IN + I_OUT + I_1 + I_2 + I_PW + I_C1); r -= l * (I_IN + I_OUT + I_1 + I_2 + I_PW + I_C1);
            if (r < I_IN) { transpose_item(w_in + (size_t)l * DM * INC, DM, INC, WIN + (size_t)l * HP * DM, scr, r, lane, SHIFT_AT, SHIFT); continue; } r -= I_IN;
            if (r < I_OUT) { transpose_item(w_out + (size_t)l * DM * DM, DM, DM, WOUT + (size_t)l * DM * DM, scr, r, lane, 1 << 30, 0); continue; } r -= I_OUT;
            if (r < I_1) { transpose_item(w_ff1 + (size_t)l * DM * FF, DM, FF, W1 + (size_t)l * FF * DM, scr, r, lane, 1 << 30, 0); continue; } r -= I_1;
            if (r < I_2) { transpose_item(w_ff2 + (size_t)l * FF * DM, FF, DM, W2 + (size_t)l * DM * FF, scr, r, lane, 1 << 30, 0); continue; } r -= I_2;
            if (r < I_PW) { transpose_item(pw_w + (size_t)l * 65536, 256, 256, WPT + (size_t)l * 65536, scr, r, lane, 1 << 30, 0); continue; } r -= I_PW;
            { const int wh = r >> 8; transpose_item(cmp_w1 + ((size_t)l * 2 + wh) * 2048 * 256, 2048, 256, W1CT + ((size_t)l * 2 + wh) * 256 * 2048, scr, r & 255, lane, 1 << 30, 0); }
        }
        for (int i = gw * 64 + lane; i < DEPTH * 116 * 128; i += NGW * 64) {
            const int l = i / (116 * 128), r = (i / 128) % 116, c = i % 128; const int row = r < 52 ? 652 + r : 3008 + (r - 52);
            *(uint4*)(WIN + ((size_t)l * HP + row) * DM + c * 8) = make_uint4(0u, 0u, 0u, 0u);
        }
        for (size_t i = (size_t)gw * 64 + lane; i < (size_t)MTOK * DM / 8; i += (size_t)NGW * 64) {
            const float4 a = ((const float4*)x)[2 * i], b = ((const float4*)x)[2 * i + 1];
            uint4 o; o.x = pk2(a.x, a.y); o.y = pk2(a.z, a.w); o.z = pk2(b.x, b.y); o.w = pk2(b.z, b.w);
            ((uint4*)XB)[i] = o;
        }
        if (blockIdx.x == 0 && tid < 256) {
            const int i = tid; const float a0 = lb_logits[i], a1 = lb_logits[256 + i], mx = fmaxf(a0, a1);
            const float e0 = expf(a0 - mx), e1 = expf(a1 - mx), p0 = e0 / (e0 + e1), p1 = e1 / (e0 + e1);
            LBS[i] = p0 - p0; LBS[256 + i] = (p0 + p1) - p0;
        }
#ifdef REP_PRO
        }
#endif
    }
    SEAM(0);

#ifdef UNROLL_L
#pragma unroll
#endif
    for (int l = 0; l < DEPTH; ++l) {
        const int pb = 1 + 8 * l;
        const float* Xin = (l == 0) ? x : out;
        if (IN(pb + 0)) {
            pg8::Gemm g{XB, WIN + (size_t)l * HP * DM, MTOK, HP, DM}; pg8::StaticOrder S; S.init(MTOK, HP, F.G, (int)blockIdx.x);
            pg8::EpiBf16<0> E{HB, HP};
            pg8::gemm_phase<pg8::EpiBf16<0>, pg8::StaticOrder, true, true>(F.lds, g, S, E);
#ifdef REP_INPROJ
            __syncthreads(); pg8::gemm_phase<pg8::EpiBf16<0>, pg8::StaticOrder, true, true>(F.lds, g, S, E);
#endif
        }
        SEAM(pb + 0);
        if (IN(pb + 1)) {
            constexpr int N_H1 = B_ * 4 * NSEG, N_CMP = 128, N_KM = B_ * 4 * 32, N_CV = MTOK / 64;
#ifdef REP_P2A
            for (int rep_ = 0; rep_ < 2; ++rep_)
#endif
            for (int u = F.vcu; u < N_H1 + N_CMP + N_KM + N_CV; u += F.G) {
                int r = u;
                #ifndef SKIP_H1
                if (r < N_H1) { hgrn1_unit<LayB>(F.lds, HB, LBS + l * 256, OL, QP, U, Dg, r);
#ifdef REP_H1
                    __syncthreads(); hgrn1_unit<LayB>(F.lds, HB, LBS + l * 256, OL, QP, U, Dg, r);
#endif
                    continue; }
#endif
                r -= N_H1;
#ifndef SKIP_CMP
                if (r < N_CMP) { cmp_unit<LayB>(F.lds, HB, cmp_pe + (size_t)l * 2 * 2048, W1CT + (size_t)l * 2 * 256 * 2048, cmp_b1 + (size_t)l * 2 * 256, cmp_w2 + (size_t)l * 2 * 256 * 64, KCV, r);
#ifdef REP_CMP
                    cmp_unit<LayB>(F.lds, HB, cmp_pe + (size_t)l * 2 * 2048, W1CT + (size_t)l * 2 * 256 * 2048, cmp_b1 + (size_t)l * 2 * 256, cmp_w2 + (size_t)l * 2 * 256 * 64, KCV, r);
#endif
                    continue; }
#endif
                r -= N_CMP;
#ifndef SKIP_KM
                if (r < N_KM) { kmean_unit<LayB>(F.lds, HB, KM, r);
#ifdef REP_KM
                    kmean_unit<LayB>(F.lds, HB, KM, r);
#endif
                    continue; }
#endif
                r -= N_KM;
#ifndef SKIP_CONV
                conv_unit<LayB>(F.lds, HB, dw_w + (size_t)l * 31 * 256, dw_b + l * 256, cln_g + l * 256, cln_b + l * 256, WPT + (size_t)l * 65536, MIX, r);
#ifdef REP_CONV
                conv_unit<LayB>(F.lds, HB, dw_w + (size_t)l * 31 * 256, dw_b + l * 256, cln_g + l * 256, cln_b + l * 256, WPT + (size_t)l * 65536, MIX, r);
#endif
#endif
            }
        }
        SEAM(pb + 1);
        if (IN(pb + 2)) {
            att::build_tabd(F.lds, rel, fresh_tid());
#ifdef REP_ATT
            for (int rep_ = 0; rep_ < 2; ++rep_)
#endif
            for (int u = F.vcu; u < 256; u += F.G) {
#ifndef SKIP_NSA
                { const int b = u >> 6, i = u & 63; const bf16_t* Hb = HB + (size_t)b * S_ * HP; bf16_t* Mb = MIX + (size_t)b * S_ * DM;
                  const bf16_t* KCb = KCV + (size_t)(0 * B_ + b) * 512 * 64; const bf16_t* VCb = KCV + (size_t)(1 * B_ + b) * 512 * 64;
                  att::nsa_block(F.lds, Hb, KCb, VCb, Mb, 127 - i);
                  att::nsa_block(F.lds, Hb, KCb, VCb, Mb, i); }
#endif
#ifndef SKIP_MOBA
                { const int b = u >> 6, hd = (u >> 4) & 3, k = u & 15; const bf16_t* Hb = HB + (size_t)b * S_ * HP; bf16_t* Mb = MIX + (size_t)b * S_ * DM;
                  const float* KMh = KM + (size_t)(b * 4 + hd) * 32 * 64;
                  att::moba_block(F.lds, Hb, KMh, Mb, hd, 31 - k);
                  att::moba_block(F.lds, Hb, KMh, Mb, hd, k); }
#endif
#ifndef SKIP_H2
                hgrn2_unit<LayB>(HB, OL, QP, U, Dg, hn_g + l * 256, MIX, u);
#endif
            }
        }
        SEAM(pb + 2);
        if (IN(pb + 3)) {
            pg8::Gemm g{MIX, WOUT + (size_t)l * DM * DM, MTOK, DM, DM}; pg8::StaticOrder S; S.init(MTOK, DM, F.G, (int)blockIdx.x);
            pg8::EpiResF32 E{Xin, out, DM, ALPHA};
            pg8::gemm_phase<pg8::EpiResF32, pg8::StaticOrder, true, true>(F.lds, g, S, E);
        }
        SEAM(pb + 3);
        if (IN(pb + 4)) {
            const int tid = fresh_tid(), lane = tid & 63, wave = __builtin_amdgcn_readfirstlane(tid >> 6);
            const int gw = F.vcu * NWAVES + wave, NGW = F.G * NWAVES;
#ifdef REP_LN
            for (int m = gw; m < MTOK; m += NGW) ln_row(out + (size_t)m * DM, ln1_g + l * DM, ln1_b + l * DM, (float*)HFF + (size_t)m * DM, XB + (size_t)m * DM, lane);
#endif
            for (int m = gw; m < MTOK; m += NGW) ln_row(out + (size_t)m * DM, ln1_g + l * DM, ln1_b + l * DM, out + (size_t)m * DM, XB + (size_t)m * DM, lane);
        }
        SEAM(pb + 4);
        if (IN(pb + 5)) {
            pg8::Gemm g{XB, W1 + (size_t)l * FF * DM, MTOK, FF, DM}; pg8::StaticOrder S; S.init(MTOK, FF, F.G, (int)blockIdx.x);
            pg8::EpiBf16<2> E{HFF, FF};
            pg8::gemm_phase<pg8::EpiBf16<2>, pg8::StaticOrder, true, true>(F.lds, g, S, E);
#ifdef REP_FF1
            __syncthreads(); pg8::gemm_phase<pg8::EpiBf16<2>, pg8::StaticOrder, true, true>(F.lds, g, S, E);
#endif
        }
        SEAM(pb + 5);
        if (IN(pb + 6)) {
            pg8::Gemm g{HFF, W2 + (size_t)l * DM * FF, MTOK, DM, FF}; pg8::StaticOrder S; S.init(MTOK, DM, F.G, (int)blockIdx.x);
            pg8::EpiResF32 E{out, out, DM, ALPHA};
            pg8::gemm_phase<pg8::EpiResF32, pg8::StaticOrder, true, true>(F.lds, g, S, E);
        }
        SEAM(pb + 6);
        if (IN(pb + 7)) {
            const int tid = fresh_tid(), lane = tid & 63, wave = __builtin_amdgcn_readfirstlane(tid >> 6);
            const int gw = F.vcu * NWAVES + wave, NGW = F.G * NWAVES;
#ifdef REP_LN
            for (int m = gw; m < MTOK; m += NGW) ln_row(out + (size_t)m * DM, ln2_g + l * DM, ln2_b + l * DM, (float*)HFF + (size_t)m * DM, XB + (size_t)m * DM, lane);
#endif
            for (int m = gw; m < MTOK; m += NGW) ln_row(out + (size_t)m * DM, ln2_g + l * DM, ln2_b + l * DM, out + (size_t)m * DM, XB + (size_t)m * DM, lane);
        }
        SEAM(pb + 7);
    }
#undef IN
#undef SEAM
}

#ifndef MK_PER_PHASE
#define MK_PER_PHASE 0
#endif
extern "C" void kernel_launch(void* const* d_in, const int* in_sizes, int n_in, void* d_out, int out_size, void* d_ws, size_t ws_size, hipStream_t stream) {
    static int grid = 0;
    if (grid == 0) {
        if (n_in != 21 || out_size != MTOK * DM || ws_size < WS_END) { fprintf(stderr, "kernel_launch: unexpected problem (n_in %d out %d ws %zu)\n", n_in, out_size, ws_size); grid = -1; return; }
        int dev = 0, cus = 0, per_cu = 0;
        if (hipGetDevice(&dev) != hipSuccess || hipDeviceGetAttribute(&cus, hipDeviceAttributeMultiprocessorCount, dev) != hipSuccess) { grid = -1; return; }
        if (hipFuncSetAttribute((const void*)mega_fwd, hipFuncAttributeMaxDynamicSharedMemorySize, LDS_BYTES) != hipSuccess) { fprintf(stderr, "kernel_launch: hipFuncSetAttribute failed\n"); grid = -1; return; }
        if (hipOccupancyMaxActiveBlocksPerMultiprocessor(&per_cu, (const void*)mega_fwd, NTHR, LDS_BYTES) != hipSuccess || per_cu < 1) { fprintf(stderr, "kernel_launch: occupancy query says %d\n", per_cu); }
        (void)hipGetLastError();
        grid = cus;
    }
    if (grid < 0) return;
    (void)hipMemsetAsync((char*)d_ws + WS_CTL, 0, CTL_ZERO_BYTES, stream);
    Args a{};
    for (int i = 0; i < 21; ++i) a.in[i] = (const float*)d_in[i];
    a.out = (float*)d_out; a.ws = (unsigned char*)d_ws;
#if MK_PER_PHASE
    for (int p = 0; p < NPHASE; ++p) { a.ph_lo = p; a.ph_hi = p + 1; hipLaunchKernelGGL(mega_fwd, dim3(grid), dim3(NTHR), LDS_BYTES, stream, a); }
#else
    a.ph_lo = 0; a.ph_hi = NPHASE;
    hipLaunchKernelGGL(mega_fwd, dim3(grid), dim3(NTHR), LDS_BYTES, stream, a);
#endif
}
```

```cpp
#include <hip/hip_runtime.h>
#include <cstdio>
#include <cstdint>
#include <cmath>

constexpr int B_ = 4, S_ = 8192, DM = 1024, DEPTH = 2, MTOK = B_ * S_;
constexpr int INC = 2956, FF = 4096, NCMP = 511;
constexpr float ALPHA = 1.4142135623730951f;
constexpr float BIGF = 1e9f;
typedef unsigned short bf16_t;
typedef float f32x4_t __attribute__((ext_vector_type(4)));
#define GAS __attribute__((address_space(1)))
#define LAS __attribute__((address_space(3)))

struct LayB { typedef bf16_t T; static constexpr int P = 3072, QN = 0, KC = 256, VC = 320, KS = 384, VS = 448, KW = 512, VW = 576, GN = 640,
              QM = 704, KM = 960, VM = 1216, CV = 1472, QH = 1984, FH = 2240, IH = 2496, GH = 2752; };
constexpr int HP = LayB::P, SHIFT_AT = 652, SHIFT = 52;

__device__ const unsigned char BUCKET_LUT[128] = {0,1,2,3,4,5,6,7,8,9,10,11,12,13,14,15,16,16,16,17,17,18,18,18,19,19,19,20,20,20,20,21,21,21,21,22,22,22,22,22,23,23,23,23,23,23,24,24,24,24,24,24,25,25,25,25,25,25,25,26,26,26,26,26,26,26,26,27,27,27,27,27,27,27,27,27,27,28,28,28,28,28,28,28,28,28,28,29,29,29,29,29,29,29,29,29,29,29,29,30,30,30,30,30,30,30,30,30,30,30,30,30,30,31,31,31,31,31,31,31,31,31,31,31,31,31,31,31};
__device__ __forceinline__ int rel_bucket(int dist) { return dist >= 128 ? 31 : (int)BUCKET_LUT[dist < 0 ? 0 : dist]; }
__device__ __forceinline__ float sigmoidf_(float x) { return 1.0f / (1.0f + expf(-x)); }
__device__ __forceinline__ float bf2f(bf16_t v) { return __uint_as_float((unsigned)v << 16); }
__device__ __forceinline__ unsigned f2bf(float f) { unsigned u = __float_as_uint(f); return (u + 0x7fffu + ((u >> 16) & 1u)) >> 16; }
__device__ __forceinline__ unsigned pk2(float lo, float hi) { return f2bf(lo) | (f2bf(hi) << 16); }
__device__ __forceinline__ float ldf(const float* p) { return *p; }
__device__ __forceinline__ float ldf(const bf16_t* p) { return bf2f(*p); }

constexpr int NWAVES = 8, NTHR = 512;
__device__ __forceinline__ int fresh_tid() { int t = threadIdx.x; asm volatile("" : "+v"(t)); return t; }
__device__ __forceinline__ void load_qp(unsigned (&qp)[32], const bf16_t* p) {
#pragma unroll
    for (int c = 0; c < 8; ++c) { const uint4 w = *(const uint4*)(p + 8 * c); qp[4 * c] = w.x; qp[4 * c + 1] = w.y; qp[4 * c + 2] = w.z; qp[4 * c + 3] = w.w; }
}
#define QLO(u) __uint_as_float((u) << 16)
#define QHI(u) __uint_as_float((u) & 0xffff0000u)
namespace pg8 {
#define PG8_LAS __attribute__((address_space(3)))
typedef unsigned short bf16_t;
typedef short bf16x8 __attribute__((ext_vector_type(8)));
typedef float f32x4 __attribute__((ext_vector_type(4)));
typedef unsigned u32x4 __attribute__((ext_vector_type(4)));
constexpr int BM = 256, BK = 64, HALF = 128, HTB = HALF * BK * 2  , STAGE_BYTES = 8 * HTB, NXCD = 8, WGM = 8;

__host__ __device__ __forceinline__ int lds_byte(int r, int c) { const int st = (r >> 4) * 2 + (c >> 5), rr = r & 15, cc = c & 31, ob = rr * 64 + cc * 2; return st * 1024 + (ob ^ (((ob >> 9) & 1) << 5)); }
__host__ __device__ __forceinline__ void stage_rc(int b, int& R, int& C) { const int st = b / 1024, sb = b % 1024, swz = sb ^ (((sb >> 9) & 1) << 5); R = (st >> 1) * 16 + swz / 64; C = (st & 1) * 32 + (swz % 64) / 2; }
__host__ __device__ __forceinline__ int perm32(int rho) { const int n = rho >> 4, i = rho & 15; return 8 * (i >> 2) + 4 * n + (i & 3); }

struct Unit { int pm, pn; };
struct Gemm { const bf16_t* A; const bf16_t* Bt; int M, N, K; };

struct StaticOrder {
    int nM, nN, nwg, G, c;
    __host__ __device__ void init(int M, int N, int G_, int c_) { nM = M / BM; nN = N / BM; nwg = nM * nN; G = G_; c = c_; }
    __host__ __device__ bool next(int i, Unit& u) const {
        const long L = (long)i * G + c; if (L >= nwg) return false;
        int wgid = (int)L; { const int q = nwg / NXCD, r = nwg % NXCD, xcd = wgid % NXCD, off = wgid / NXCD; wgid = (xcd < r ? xcd * (q + 1) : r * (q + 1) + (xcd - r) * q) + off; }
        const int nig = WGM * nN, gid = wgid / nig, fm = gid * WGM, gsz = (nM - fm) < WGM ? (nM - fm) : WGM;
        u.pm = fm + ((wgid % nig) % gsz); u.pn = (wgid % nig) / gsz; return true;
    }
    __device__ __forceinline__ void a_ready(const Unit&) const {}
    __device__ __forceinline__ void done(const Unit&) const {}
};


__device__ __forceinline__ unsigned cvt_pk_bf16(float lo, float hi) { unsigned r; asm volatile("v_cvt_pk_bf16_f32 %0, %1, %2" : "=v"(r) : "v"(lo), "v"(hi)); return r; }
template <int ACT  > struct EpiBf16 {
    static constexpr bool PERM = true, AFTER_DRAIN = false;
    bf16_t* O; int ldc;
    __device__ __forceinline__ void operator()(const f32x4 (&acc)[2][2][4][2], const Unit& u, int wr, int wc, int fr, int fq) const {
        const int row0 = u.pm * BM + wr * 64 + fr; const int col0 = u.pn * BM + wc * 32 + 8 * fq;
#pragma unroll
        for (int ai = 0; ai < 2; ++ai)
#pragma unroll
            for (int m = 0; m < 4; ++m) { bf16_t* rowp = O + (size_t)(row0 + ai * HALF + m * 16) * ldc + col0;
#pragma unroll
                for (int bj = 0; bj < 2; ++bj) { f32x4 v0 = acc[ai][bj][m][0], v1 = acc[ai][bj][m][1];
                    if (ACT == 2) {
#pragma unroll
                        for (int e = 0; e < 4; ++e) { const float a = v0[e] > 0.f ? v0[e] : 0.f, b = v1[e] > 0.f ? v1[e] : 0.f; v0[e] = a * a; v1[e] = b * b; } }
                    u32x4 w; w.x = cvt_pk_bf16(v0[0], v0[1]); w.y = cvt_pk_bf16(v0[2], v0[3]); w.z = cvt_pk_bf16(v1[0], v1[1]); w.w = cvt_pk_bf16(v1[2], v1[3]);
                    *(u32x4*)(rowp + bj * HALF) = w; } }
    }
};
struct EpiResF32 {
    static constexpr bool PERM = false, AFTER_DRAIN = false;
    const float* base; float* out; int ldc; float alpha;
    __device__ __forceinline__ void operator()(const f32x4 (&acc)[2][2][4][2], const Unit& u, int wr, int wc, int fr, int fq) const {
        const int col0 = u.pn * BM + wc * 32 + 4 * fq;
#pragma unroll
        for (int ai = 0; ai < 2; ++ai)
#pragma unroll
            for (int m = 0; m < 4; ++m) { const int r = ai * HALF + wr * 64 + m * 16 + fr; const size_t off = (size_t)(u.pm * BM + r) * ldc + col0;
#pragma unroll
                for (int bj = 0; bj < 2; ++bj)
#pragma unroll
                    for (int n = 0; n < 2; ++n) { const f32x4 bs = *(const f32x4*)(base + off + bj * HALF + n * 16); *(f32x4*)(out + off + bj * HALF + n * 16) = bs * alpha + acc[ai][bj][m][n]; }
                if (m & 1) asm volatile("" ::: "memory"); }
    }
};

template <class Epi, class Sched, bool ALIGN_EPI = false, bool SP2 = false>
__device__ __forceinline__ void gemm_phase(PG8_LAS unsigned char* lds, const Gemm g, const Sched& S, const Epi& E) {
    int tid_ = threadIdx.x; asm volatile("" : "+v"(tid_)); const int tid = tid_, wid = __builtin_amdgcn_readfirstlane(tid >> 6), lane = tid & 63, wr = wid >> 2, wc = wid & 3, fr = lane & 15, fq = lane >> 4;
    const int K = g.K, nt = K / BK;
    unsigned voffA[2], voffB[2];
#pragma unroll
    for (int i = 0; i < 2; ++i) { int R, C; stage_rc(tid * 16 + i * 8192, R, C); const int Rb = Epi::PERM ? ((R & ~31) + perm32(R & 31)) : R;
        voffA[i] = (unsigned)(R * K + C) * 2u; voffB[i] = (unsigned)(Rb * K + C) * 2u; }
    const size_t kstep = (size_t)(BK * 2);
    const size_t hstep = (size_t)HALF * K * 2;
    const size_t tstep = 2 * hstep;
    const unsigned ldsw = (unsigned)wid * 1024u;
    const int aoff = lds_byte(wr * 64 + fr, fq * 8), boff = lds_byte(wc * 32 + fr, fq * 8);
#define PG8_SA(b, h) (((b) * 2 + (h)) * HTB)
#define PG8_SB(b, h) ((4 + (b) * 2 + (h)) * HTB)
#define PG8_STAGE(bufoff, gbase, voff) do { _Pragma("unroll") for (int _i = 0; _i < 2; ++_i) \
        __builtin_amdgcn_global_load_lds((const unsigned*)((const char*)(gbase) + (voff)[_i]), (PG8_LAS unsigned*)(lds + (bufoff) + ldsw + _i * 8192), 16, 0, 0); } while (0)
#define PG8_LDA(dst, b, h) do { _Pragma("unroll") for (int m = 0; m < 4; ++m) _Pragma("unroll") for (int k = 0; k < 2; ++k) dst[m][k] = *(const PG8_LAS bf16x8*)(lds + PG8_SA(b, h) + aoff + m * 2048 + k * 1024); } while (0)
#define PG8_LDB(dst, b, h) do { _Pragma("unroll") for (int n = 0; n < 2; ++n) _Pragma("unroll") for (int k = 0; k < 2; ++k) dst[n][k] = *(const PG8_LAS bf16x8*)(lds + PG8_SB(b, h) + boff + n * 2048 + k * 1024); } while (0)
#define PG8_MMA(ai, bj, At, Bt) do { __builtin_amdgcn_s_setprio(1); _Pragma("unroll") for (int m = 0; m < 4; ++m) _Pragma("unroll") for (int n = 0; n < 2; ++n) _Pragma("unroll") for (int k = 0; k < 2; ++k) \
        acc[ai][bj][m][n] = __builtin_amdgcn_mfma_f32_16x16x32_bf16(Bt[n][k], At[m][k], acc[ai][bj][m][n], 0, 0, 0); __builtin_amdgcn_s_setprio(0); } while (0)
#define PG8_WAIT_V(n) asm volatile("s_waitcnt vmcnt(" #n ")" ::: "memory")
#define PG8_WAIT_L(n) asm volatile("s_waitcnt lgkmcnt(" #n ")" ::: "memory")
#define PG8_BAR __builtin_amdgcn_s_barrier()
#define PG8_SCHED __builtin_amdgcn_sched_barrier(0)
    Unit cur, nxt; int ui = 0;
    if (!S.next(0, cur)) return;
    f32x4 acc[2][2][4][2];
#pragma unroll
    for (int a = 0; a < 2; ++a)
#pragma unroll
        for (int b = 0; b < 2; ++b)
#pragma unroll
            for (int m = 0; m < 4; ++m)
#pragma unroll
                for (int n = 0; n < 2; ++n) acc[a][b][m][n] = (f32x4){0.f, 0.f, 0.f, 0.f};
    bf16x8 At[4][2], B0[2][2], B1[2][2];
    const char* cA = (const char*)g.A + (size_t)cur.pm * tstep; const char* cB = (const char*)g.Bt + (size_t)cur.pn * tstep;
    S.a_ready(cur);
    if constexpr (SP2) {
        PG8_STAGE(PG8_SB(0, 0), cB, voffB); PG8_STAGE(PG8_SB(0, 1), cB + hstep, voffB); PG8_STAGE(PG8_SA(0, 0), cA, voffA); PG8_STAGE(PG8_SA(0, 1), cA + hstep, voffA);
        if (wr == 1) PG8_BAR;
        PG8_WAIT_V(2); PG8_BAR;
        PG8_STAGE(PG8_SB(1, 0), cB + kstep, voffB); PG8_STAGE(PG8_SA(1, 0), cA + kstep, voffA); PG8_STAGE(PG8_SB(1, 1), cB + hstep + kstep, voffB);
        PG8_WAIT_V(6); PG8_BAR;
    } else {
        PG8_STAGE(PG8_SB(0, 0), cB, voffB); PG8_STAGE(PG8_SA(0, 0), cA, voffA); PG8_STAGE(PG8_SB(0, 1), cB + hstep, voffB); PG8_STAGE(PG8_SA(0, 1), cA + hstep, voffA);
        if (wr == 1) PG8_BAR;
        PG8_WAIT_V(4); PG8_BAR;
        PG8_STAGE(PG8_SB(1, 0), cB + kstep, voffB); PG8_STAGE(PG8_SA(1, 0), cA + kstep, voffA); PG8_STAGE(PG8_SB(1, 1), cB + hstep + kstep, voffB);
        PG8_WAIT_V(6); PG8_BAR;
    }
    for (;;) {
        const bool has_next = S.next(ui + 1, nxt);
        const char* nA = has_next ? (const char*)g.A + (size_t)nxt.pm * tstep : cA; const char* nB = has_next ? (const char*)g.Bt + (size_t)nxt.pn * tstep : cB;
        for (int t = 0; t < nt; t += 2) {
            const bool last = (t == nt - 2);
            const char* a1 = cA + (size_t)(t + 1) * kstep;
            const char* a2 = last ? nA : cA + (size_t)(t + 2) * kstep; const char* b2 = last ? nB : cB + (size_t)(t + 2) * kstep;
            const char* a3 = a2 + kstep; const char* b3 = b2 + kstep;
            if (last && has_next) S.a_ready(nxt);
            if constexpr (SP2) {
            PG8_LDB(B0, 0, 0); PG8_LDB(B1, 0, 1); PG8_SCHED; PG8_LDA(At, 0, 0); PG8_STAGE(PG8_SA(1, 1), a1 + hstep, voffA);
            PG8_WAIT_V(8); PG8_WAIT_L(0); PG8_BAR; PG8_MMA(0, 0, At, B0); PG8_MMA(0, 1, At, B1); PG8_BAR; PG8_SCHED;
            PG8_LDA(At, 0, 1); PG8_STAGE(PG8_SB(0, 0), b2, voffB); PG8_STAGE(PG8_SB(0, 1), b2 + hstep, voffB); PG8_STAGE(PG8_SA(0, 0), a2, voffA);
            PG8_WAIT_V(8); PG8_WAIT_L(0); PG8_BAR; PG8_MMA(1, 0, At, B0); PG8_MMA(1, 1, At, B1); PG8_BAR; PG8_SCHED;
            PG8_LDB(B0, 1, 0); PG8_LDB(B1, 1, 1); PG8_SCHED; PG8_LDA(At, 1, 0); PG8_STAGE(PG8_SA(0, 1), a2 + hstep, voffA);
            PG8_WAIT_V(8); PG8_WAIT_L(0); PG8_BAR; PG8_MMA(0, 0, At, B0); PG8_MMA(0, 1, At, B1); PG8_BAR; PG8_SCHED;
            PG8_LDA(At, 1, 1); PG8_STAGE(PG8_SB(1, 0), b3, voffB); PG8_STAGE(PG8_SB(1, 1), b3 + hstep, voffB); PG8_STAGE(PG8_SA(1, 0), a3, voffA);
            PG8_WAIT_V(8); PG8_WAIT_L(0); PG8_BAR; PG8_MMA(1, 0, At, B0); PG8_MMA(1, 1, At, B1); PG8_BAR; PG8_SCHED;
            } else {
            PG8_LDB(B0, 0, 0); PG8_SCHED; PG8_LDA(At, 0, 0); PG8_STAGE(PG8_SA(1, 1), a1 + hstep, voffA);
            PG8_WAIT_L(8); PG8_BAR; PG8_WAIT_L(0); PG8_MMA(0, 0, At, B0); PG8_BAR; PG8_SCHED;
            PG8_LDB(B1, 0, 1); PG8_STAGE(PG8_SB(0, 0), b2, voffB);
            PG8_BAR; PG8_WAIT_L(0); PG8_MMA(0, 1, At, B1); PG8_BAR;
            PG8_LDA(At, 0, 1); PG8_STAGE(PG8_SA(0, 0), a2, voffA);
            PG8_BAR; PG8_WAIT_L(0); PG8_MMA(1, 0, At, B0); PG8_BAR; PG8_SCHED;
            PG8_STAGE(PG8_SB(0, 1), b2 + hstep, voffB);
            PG8_WAIT_V(6); PG8_BAR; PG8_MMA(1, 1, At, B1); PG8_BAR;
            PG8_LDB(B0, 1, 0); PG8_SCHED; PG8_LDA(At, 1, 0); PG8_STAGE(PG8_SA(0, 1), a2 + hstep, voffA);
            PG8_WAIT_L(8); PG8_BAR; PG8_WAIT_L(0); PG8_MMA(0, 0, At, B0); PG8_BAR; PG8_SCHED;
            PG8_LDB(B1, 1, 1); PG8_STAGE(PG8_SB(1, 0), b3, voffB);
            PG8_BAR; PG8_WAIT_L(0); PG8_MMA(0, 1, At, B1); PG8_BAR;
            PG8_LDA(At, 1, 1); PG8_STAGE(PG8_SA(1, 0), a3, voffA);
            PG8_BAR; PG8_WAIT_L(0); PG8_MMA(1, 0, At, B0); PG8_BAR; PG8_SCHED;
            PG8_STAGE(PG8_SB(1, 1), b3 + hstep, voffB);
            PG8_WAIT_V(6); PG8_BAR; PG8_MMA(1, 1, At, B1); PG8_BAR;
            }
        }
        if constexpr (ALIGN_EPI) { if (wr == 0) PG8_BAR; }
        if constexpr (!Epi::AFTER_DRAIN) { E(acc, cur, wr, wc, fr, fq); S.done(cur); }
        if (!has_next) break;
#pragma unroll
        for (int a = 0; a < 2; ++a)
#pragma unroll
            for (int b = 0; b < 2; ++b)
#pragma unroll
                for (int m = 0; m < 4; ++m)
#pragma unroll
                    for (int n = 0; n < 2; ++n) acc[a][b][m][n] = (f32x4){0.f, 0.f, 0.f, 0.f};
        cur = nxt; cA = nA; cB = nB; ++ui;
        if constexpr (ALIGN_EPI) { if (wr == 1) PG8_BAR; }
    }
    PG8_WAIT_V(0);
    if constexpr (!ALIGN_EPI) { if (wr == 0) PG8_BAR; }
    PG8_BAR;
    if constexpr (Epi::AFTER_DRAIN) { E.fused(acc, cur, wr, wc, fr, fq, lds, wid, lane); S.done(cur); }
#undef PG8_SA
#undef PG8_SB
#undef PG8_STAGE
#undef PG8_LDA
#undef PG8_LDB
#undef PG8_MMA
#undef PG8_WAIT_V
#undef PG8_WAIT_L
#undef PG8_BAR
#undef PG8_SCHED
}
}

#define XB_TMO      128
#define XB_XCNT(j)  (256  + 64 * (j))
#define XB_XSUB(j)  (1280 + 64 * (j))
#define XB_XGEN(j)  (2304 + 64 * (j))
#define XB_TOP      3328
#define XB_TOPGEN   3392
#define XCD_BAR_WORDS 3456
#define XB_SPIN_CAP (1u << 26)

__device__ __forceinline__ unsigned xb_ld(unsigned* p)              { return __hip_atomic_load(p, __ATOMIC_RELAXED, __HIP_MEMORY_SCOPE_AGENT); }
__device__ __forceinline__ unsigned xb_add(unsigned* p, unsigned v) { return __hip_atomic_fetch_add(p, v, __ATOMIC_RELAXED, __HIP_MEMORY_SCOPE_AGENT); }
__device__ __forceinline__ unsigned xb_xcc_id() { return (unsigned)__builtin_amdgcn_s_getreg((3 << 11) | 20) & 0xFu; }
#define XB_SPIN(cond, bar) do { unsigned _sp = 0; while (cond) { __builtin_amdgcn_s_sleep(1); \
    if ((++_sp & 255u) == 0u) { if (xb_ld(&(bar)[XB_TMO])) break; if (_sp > XB_SPIN_CAP) { atomicAdd(&(bar)[XB_TMO], 1u); break; } } } } while (0)

struct XcdBarrier {
    unsigned* bar; unsigned x;
    volatile LAS unsigned* st;
};

__device__ __forceinline__ XcdBarrier xcd_barrier_post(unsigned* bar, volatile LAS unsigned* st) {
    XcdBarrier b; b.bar = bar; b.x = xb_xcc_id(); b.st = st;
    if (threadIdx.x == 0) (void)xb_add(&bar[XB_XCNT(b.x)], 1u);
    return b;
}
__device__ __forceinline__ void xcd_barrier_complete(unsigned* bar, unsigned x, unsigned& nloc, unsigned& nx) {
    const unsigned G = gridDim.x * gridDim.y * gridDim.z;
    unsigned sum, cnt, mine, sp = 0u;
    for (;;) {
        sum = 0u; cnt = 0u; mine = 0u;
#pragma unroll
        for (unsigned j = 0; j < 16; ++j) { const unsigned c = xb_ld(&bar[XB_XCNT(j)]); sum += c; cnt += (c > 0u) ? 1u : 0u; mine = (j == x) ? c : mine; }
        if (sum == G) break;
        __builtin_amdgcn_s_sleep(1);
        if ((++sp & 255u) == 0u) { if (xb_ld(&bar[XB_TMO])) break; if (sp > XB_SPIN_CAP) { atomicAdd(&bar[XB_TMO], 1u); break; } }
    }
    nloc = mine > 0u ? mine : 1u; nx = cnt > 0u ? cnt : 1u;
}

__device__ __forceinline__ void xcd_barrier(const XcdBarrier& b) {
    asm volatile("s_waitcnt vmcnt(0)" ::: "memory");
    __syncthreads();
    if (threadIdx.x == 0) {
        unsigned* bar = b.bar;
        __builtin_amdgcn_s_waitcnt(0);
        unsigned nloc = b.st[0], nx = b.st[1];
        if (nloc == 0u) { xcd_barrier_complete(bar, b.x, nloc, nx); b.st[0] = nloc; b.st[1] = nx; }
        const unsigned old = xb_add(&bar[XB_XSUB(b.x)], 1u);
        const unsigned gen = old / nloc;
        if (old + 1u == (gen + 1u) * nloc) {
            __builtin_amdgcn_fence(__ATOMIC_RELEASE, "agent");
            asm volatile("s_waitcnt vmcnt(0)" ::: "memory");
            const unsigned og = xb_add(&bar[XB_TOP], 1u);
            const unsigned tg = og / nx;
            if (og + 1u == (tg + 1u) * nx) xb_add(&bar[XB_TOPGEN], 1u);
            else XB_SPIN(xb_ld(&bar[XB_TOPGEN]) == tg, bar);
            __builtin_amdgcn_fence(__ATOMIC_ACQUIRE, "agent");
            xb_add(&bar[XB_XGEN(b.x)], 1u);
            asm volatile("s_waitcnt vmcnt(0)" ::: "memory");
        } else {
            XB_SPIN(xb_ld(&bar[XB_XGEN(b.x)]) == gen, bar);
            __builtin_amdgcn_fence(__ATOMIC_ACQUIRE, "agent");
            asm volatile("s_waitcnt vmcnt(0)" ::: "memory");
        }
    }
    __syncthreads();
}


constexpr size_t MiB = 1u << 20;
constexpr size_t WS_CTL = 0, CTL_ZERO_BYTES = 1 * MiB;
constexpr size_t WS_WIN = 1 * MiB;
constexpr size_t WS_WOUT = WS_WIN + 12 * MiB;
constexpr size_t WS_W1 = WS_WOUT + 4 * MiB;
constexpr size_t WS_W2 = WS_W1 + 16 * MiB;
constexpr size_t WS_XB = WS_W2 + 16 * MiB;
constexpr size_t WS_H = WS_XB + 64 * MiB;
constexpr size_t WS_MIX = WS_H + 192 * MiB;
constexpr size_t WS_HFF = WS_H;
constexpr size_t WS_KCV = WS_H + 256 * MiB;
constexpr size_t WS_KM = WS_KCV + 2 * MiB;
constexpr size_t WS_OL = WS_KM + 1 * MiB;
constexpr size_t WS_QP = WS_OL + 32 * MiB;
constexpr size_t WS_U = WS_QP + 32 * MiB;
constexpr size_t WS_DG = WS_U + 4 * MiB;
constexpr size_t WS_LBS = WS_DG + 1 * MiB;
constexpr size_t WS_RES = WS_LBS + 1 * MiB;
constexpr size_t WS_WPT = WS_RES;
constexpr size_t WS_W1CT = WS_RES + 1 * MiB;
constexpr size_t WS_END = WS_RES + 32 * MiB;
static_assert(WS_END <= 512 * MiB, "workspace map");
constexpr int CW_BAR = 4096;
constexpr int RING_BYTES = 131072, LDSCTL_OFF = RING_BYTES, MISC_OFF = LDSCTL_OFF + 320, LDS_BYTES = 147456;
constexpr int HSEG = 512, NSEG = S_ / HSEG, HT = 32;

__device__ __forceinline__ float dot64(const float (&q)[64], const float* __restrict__ k) {
    float s0 = 0.f, s1 = 0.f, s2 = 0.f, s3 = 0.f;
#pragma unroll
    for (int d = 0; d < 64; d += 4) { const float4 kv = *(const float4*)(k + d); s0 = fmaf(q[d], kv.x, s0); s1 = fmaf(q[d + 1], kv.y, s1); s2 = fmaf(q[d + 2], kv.z, s2); s3 = fmaf(q[d + 3], kv.w, s3); }
    return (s0 + s1) + (s2 + s3);
}
__device__ __forceinline__ float dot64(const float (&q)[64], const bf16_t* __restrict__ k) {
    float s0 = 0.f, s1 = 0.f, s2 = 0.f, s3 = 0.f;
#pragma unroll
    for (int c = 0; c < 8; ++c) { const uint4 w = *(const uint4*)(k + 8 * c);
        s0 = fmaf(q[8 * c + 0], __uint_as_float(w.x << 16), s0); s1 = fmaf(q[8 * c + 1], __uint_as_float(w.x & 0xffff0000u), s1);
        s2 = fmaf(q[8 * c + 2], __uint_as_float(w.y << 16), s2); s3 = fmaf(q[8 * c + 3], __uint_as_float(w.y & 0xffff0000u), s3);
        s0 = fmaf(q[8 * c + 4], __uint_as_float(w.z << 16), s0); s1 = fmaf(q[8 * c + 5], __uint_as_float(w.z & 0xffff0000u), s1);
        s2 = fmaf(q[8 * c + 6], __uint_as_float(w.w << 16), s2); s3 = fmaf(q[8 * c + 7], __uint_as_float(w.w & 0xffff0000u), s3); }
    return (s0 + s1) + (s2 + s3);
}
__device__ __forceinline__ void axpy64(float p, const float* __restrict__ v, float (&o)[64]) {
#pragma unroll
    for (int d = 0; d < 64; d += 4) { const float4 vv = *(const float4*)(v + d); o[d] = fmaf(p, vv.x, o[d]); o[d + 1] = fmaf(p, vv.y, o[d + 1]); o[d + 2] = fmaf(p, vv.z, o[d + 2]); o[d + 3] = fmaf(p, vv.w, o[d + 3]); }
}
__device__ __forceinline__ void axpy64(float p, const bf16_t* __restrict__ v, float (&o)[64]) {
#pragma unroll
    for (int c = 0; c < 8; ++c) { const uint4 w = *(const uint4*)(v + 8 * c);
        o[8 * c + 0] = fmaf(p, __uint_as_float(w.x << 16), o[8 * c + 0]); o[8 * c + 1] = fmaf(p, __uint_as_float(w.x & 0xffff0000u), o[8 * c + 1]);
        o[8 * c + 2] = fmaf(p, __uint_as_float(w.y << 16), o[8 * c + 2]); o[8 * c + 3] = fmaf(p, __uint_as_float(w.y & 0xffff0000u), o[8 * c + 3]);
        o[8 * c + 4] = fmaf(p, __uint_as_float(w.z << 16), o[8 * c + 4]); o[8 * c + 5] = fmaf(p, __uint_as_float(w.z & 0xffff0000u), o[8 * c + 5]);
        o[8 * c + 6] = fmaf(p, __uint_as_float(w.w << 16), o[8 * c + 6]); o[8 * c + 7] = fmaf(p, __uint_as_float(w.w & 0xffff0000u), o[8 * c + 7]); }
}
template <typename TV>
__device__ __forceinline__ void osm_step(float s, const TV* __restrict__ v, float& m, float& l, float (&o)[64]) {
    if (s > m) { const float f = expf(m - s); l *= f;
#pragma unroll
        for (int d = 0; d < 64; ++d) o[d] *= f;
        m = s; }
    const float p = expf(s - m); l += p;
    axpy64(p, v, o);
}
__device__ __forceinline__ void load_q64(float (&q)[64], const float* p, float sc) {
#pragma unroll
    for (int d = 0; d < 64; ++d) q[d] = p[d] * sc;
}
__device__ __forceinline__ void load_q64(float (&q)[64], const bf16_t* p, float sc) {
#pragma unroll
    for (int c = 0; c < 8; ++c) { const uint4 w = *(const uint4*)(p + 8 * c);
        q[8 * c + 0] = __uint_as_float(w.x << 16) * sc; q[8 * c + 1] = __uint_as_float(w.x & 0xffff0000u) * sc; q[8 * c + 2] = __uint_as_float(w.y << 16) * sc; q[8 * c + 3] = __uint_as_float(w.y & 0xffff0000u) * sc;
        q[8 * c + 4] = __uint_as_float(w.z << 16) * sc; q[8 * c + 5] = __uint_as_float(w.z & 0xffff0000u) * sc; q[8 * c + 6] = __uint_as_float(w.w << 16) * sc; q[8 * c + 7] = __uint_as_float(w.w & 0xffff0000u) * sc; }
}
__device__ __forceinline__ void store_row64(bf16_t* p, const float (&o)[64], float sc) {
#pragma unroll
    for (int c = 0; c < 8; ++c) { uint4 w; w.x = pk2(o[8 * c] * sc, o[8 * c + 1] * sc); w.y = pk2(o[8 * c + 2] * sc, o[8 * c + 3] * sc); w.z = pk2(o[8 * c + 4] * sc, o[8 * c + 5] * sc); w.w = pk2(o[8 * c + 6] * sc, o[8 * c + 7] * sc); *(uint4*)(p + 8 * c) = w; }
}


namespace att {
typedef short bf16x8 __attribute__((ext_vector_type(8)));
typedef short s16x4 __attribute__((ext_vector_type(4)));
typedef short v4i16_t __attribute__((ext_vector_type(4)));
typedef float f32x16 __attribute__((ext_vector_type(16)));
typedef unsigned u32x4 __attribute__((ext_vector_type(4)));
typedef float f32x2_t __attribute__((ext_vector_type(2)));
typedef __bf16 bf16x2_t __attribute__((ext_vector_type(2)));
constexpr float LOG2E = 1.4426950408889634f, C2 = 0.125f * LOG2E, NEG_INF = -INFINITY, M_INIT = -1e30f, THR = 8.0f;
constexpr int L_KV = 0, KVBUF = 16384, NSLOT = 4, L_WSF = 65536, L_TABD = 67584, L_IMP = 71680, L_SEL = 104960, L_OST = 0  , L_END = 105984;
typedef LAS const unsigned char* lcp;

__device__ __forceinline__ int crow(int r, int hi) { return (r & 3) + 8 * (r >> 2) + 4 * hi; }
__device__ __forceinline__ unsigned cvtpk(float lo, float hi) { f32x2_t v = {lo, hi}; bf16x2_t b = __builtin_convertvector(v, bf16x2_t); return __builtin_bit_cast(unsigned, b); }
__device__ __forceinline__ float swapmax(float m) { auto rr = __builtin_amdgcn_permlane32_swap(__float_as_uint(m), __float_as_uint(m), false, false); return fmaxf(__uint_as_float(rr[0]), __uint_as_float(rr[1])); }
__device__ __forceinline__ float swapsum(float m) { auto rr = __builtin_amdgcn_permlane32_swap(__float_as_uint(m), __float_as_uint(m), false, false); return __uint_as_float(rr[0]) + __uint_as_float(rr[1]); }

__device__ __forceinline__ void glds16(const void* gsrc, unsigned lds_dst) { unsigned keep;
    asm volatile("s_mov_b32 %0, m0\n\ts_mov_b32 m0, %2\n\ts_nop 0\n\tglobal_load_lds_dwordx4 %1, off\n\ts_mov_b32 m0, %0" : "=&s"(keep) : "v"(gsrc), "s"(lds_dst) : "memory"); }
template <bool WITHV>
__device__ __forceinline__ void kv_dma(const bf16_t* Kp, const bf16_t* Vp, int row0, int pitch, unsigned slot_addr) {
    const int tid = fresh_tid(), lane = tid & 63, wid = __builtin_amdgcn_readfirstlane(tid >> 6);
    glds16(Kp + (size_t)(row0 + lane) * pitch + wid * 8, (unsigned)__builtin_amdgcn_readfirstlane(slot_addr + wid * 1024));
    if (WITHV) glds16(Vp + (size_t)(row0 + 16 * (wid & 3) + (lane >> 2)) * pitch + (wid >> 2) * 32 + (lane & 3) * 8, (unsigned)__builtin_amdgcn_readfirstlane(slot_addr + 8192 + wid * 1024));
}
__device__ __forceinline__ void wait_tiles(int n  ) {
    if (n >= 4) asm volatile("s_waitcnt vmcnt(4) lgkmcnt(0)" ::: "memory");
    else if (n == 2) asm volatile("s_waitcnt vmcnt(2) lgkmcnt(0)" ::: "memory");
    else if (n == 1) asm volatile("s_waitcnt vmcnt(1) lgkmcnt(0)" ::: "memory");
    else asm volatile("s_waitcnt vmcnt(0) lgkmcnt(0)" ::: "memory");
    __builtin_amdgcn_s_barrier();
    asm volatile("" ::: "memory");
}
__device__ __forceinline__ void qk_tile(f32x16& p0, f32x16& p1, lcp Kb, const bf16x8 (&qr)[4], int r32_unused, int hi_unused) {
    const int ln = fresh_tid() & 63; lcp kb = Kb + (ln >> 5) * 1024 + (ln & 31) * 16;
    const f32x16 z = {0.f, 0.f, 0.f, 0.f, 0.f, 0.f, 0.f, 0.f, 0.f, 0.f, 0.f, 0.f, 0.f, 0.f, 0.f, 0.f};
    p0 = z; p1 = z;
#pragma unroll
    for (int d0 = 0; d0 < 4; ++d0) {
        const bf16x8 b0 = *(const LAS bf16x8*)(kb + d0 * 2048), b1 = *(const LAS bf16x8*)(kb + d0 * 2048 + 512);
        p0 = __builtin_amdgcn_mfma_f32_32x32x16_bf16(b0, qr[d0], p0, 0, 0, 0);
        p1 = __builtin_amdgcn_mfma_f32_32x32x16_bf16(b1, qr[d0], p1, 0, 0, 0);
    }
}
__device__ __forceinline__ s16x4 vtr(lcp p) { return __builtin_bit_cast(s16x4, __builtin_amdgcn_ds_read_tr16_b64_v4i16((LAS v4i16_t*)p)); }
__device__ __forceinline__ void pv_tile(f32x16 (&o)[2], lcp Vb, const f32x16& p0, const f32x16& p1, int lane, int hi) {
    u32x4 pw[4];
#pragma unroll
    for (int i = 0; i < 4; ++i) { pw[0][i] = cvtpk(p0[2 * i], p0[2 * i + 1]); pw[1][i] = cvtpk(p0[8 + 2 * i], p0[9 + 2 * i]); pw[2][i] = cvtpk(p1[2 * i], p1[2 * i + 1]); pw[3][i] = cvtpk(p1[8 + 2 * i], p1[9 + 2 * i]); }
    const int ln = fresh_tid() & 63; lcp vp = Vb + ((ln >> 4) & 1) * 32 + (ln & 3) * 8 + (4 * (ln >> 5) + ((ln & 15) >> 2)) * 64;
#pragma unroll
    for (int d0 = 0; d0 < 2; ++d0)
#pragma unroll
        for (int ks = 0; ks < 4; ++ks) {
            const s16x4 lo = vtr(vp + d0 * 4096 + ks * 1024), hh = vtr(vp + d0 * 4096 + ks * 1024 + 512);
            const bf16x8 vf = {lo[0], lo[1], lo[2], lo[3], hh[0], hh[1], hh[2], hh[3]};
            o[d0] = __builtin_amdgcn_mfma_f32_32x32x16_bf16(__builtin_bit_cast(bf16x8, pw[ks]), vf, o[d0], 0, 0, 0);
        }
}
__device__ __forceinline__ void bias_far(f32x16& p0, f32x16& p1, float b) {
#pragma unroll
    for (int r = 0; r < 16; ++r) { p0[r] = fmaf(p0[r], C2, b); p1[r] = fmaf(p1[r], C2, b); }
}
template <int STRIDE, int W>
__device__ __forceinline__ void bias_near(f32x16& p0, f32x16& p1, int D0, const LAS float* tabdh, bool colok, int hi) {
    int Dh = D0 - STRIDE * 4 * hi; asm volatile("" : "+v"(Dh));
#pragma unroll
    for (int r = 0; r < 16; ++r) {
        const int d0 = Dh - STRIDE * ((r & 3) + 8 * (r >> 2)), d1 = d0 - STRIDE * 32;
        const float b0 = tabdh[d0 < 0 ? 0 : (d0 > 127 ? 127 : d0)], b1 = tabdh[d1 < 0 ? 0 : (d1 > 127 ? 127 : d1)];
        p0[r] = (colok && d0 >= 0 && d0 < W) ? fmaf(p0[r], C2, b0) : NEG_INF;
        p1[r] = (colok && d1 >= 0 && d1 < W) ? fmaf(p1[r], C2, b1) : NEG_INF;
    }
}
__device__ __forceinline__ float rowmax32(const f32x16& p0, const f32x16& p1) {
    float a = fmaxf(p0[0], p1[0]);
#pragma unroll
    for (int r = 1; r < 16; ++r) a = fmaxf(a, fmaxf(p0[r], p1[r]));
    return swapmax(a);
}
__device__ __forceinline__ void scale_rows(f32x16 (&o)[2], float f, LAS float* wsf, int r32, int hi) {
    if (hi == 0) wsf[r32] = f;
    asm volatile("s_waitcnt lgkmcnt(0)" ::: "memory");
#pragma unroll
    for (int g = 0; g < 4; ++g) { const f32x4_t fv = *(const LAS f32x4_t*)(wsf + 8 * g + 4 * hi);
#pragma unroll
        for (int i = 0; i < 4; ++i) { o[0][4 * g + i] *= fv[i]; o[1][4 * g + i] *= fv[i]; } }
    asm volatile("" : "+v"(o[0]), "+v"(o[1]));
    asm volatile("s_waitcnt lgkmcnt(0)" ::: "memory");
}
__device__ __forceinline__ void axpy_rows(unsigned (&accp)[2][8], const f32x16 (&o)[2], float f, LAS float* wsf, int r32, int hi) {
    if (hi == 0) wsf[r32] = f;
    asm volatile("s_waitcnt lgkmcnt(0)" ::: "memory");
#pragma unroll
    for (int g = 0; g < 4; ++g) { const f32x4_t fv = *(const LAS f32x4_t*)(wsf + 8 * g + 4 * hi);
#pragma unroll
        for (int d = 0; d < 2; ++d)
#pragma unroll
            for (int i = 0; i < 2; ++i) { const unsigned w = accp[d][2 * g + i];
                accp[d][2 * g + i] = cvtpk(fmaf(fv[2 * i], o[d][4 * g + 2 * i], QLO(w)), fmaf(fv[2 * i + 1], o[d][4 * g + 2 * i + 1], QHI(w))); asm volatile("" : "+v"(accp[d][2 * g + i])); } }
    asm volatile("s_waitcnt lgkmcnt(0)" ::: "memory");
}
__device__ __forceinline__ void osm_update(f32x16& p0, f32x16& p1, float& m, float& l, f32x16 (&o)[2], LAS float* wsf, int r32, int hi) {
    const float rm = rowmax32(p0, p1);
    if (__any(rm > m + THR)) {
        const float mn = fmaxf(m, rm), f = __builtin_amdgcn_exp2f(m - mn);
        l *= f; m = mn;
        scale_rows(o, f, wsf, r32, hi);
    }
    float s = 0.f;
#pragma unroll
    for (int r = 0; r < 16; ++r) { p0[r] = __builtin_amdgcn_exp2f(p0[r] - m); p1[r] = __builtin_amdgcn_exp2f(p1[r] - m); s += p0[r] + p1[r]; }
    l += s;
}
template <class RowOff>
__device__ __forceinline__ void store_cols(const f32x16 (&acc)[2], LAS unsigned char* stg, bf16_t* dst, const RowOff& ro, int lane, int r32, int hi) {
    LAS bf16_t* s = (LAS bf16_t*)stg;
#pragma unroll
    for (int r = 0; r < 16; ++r) { const int q = crow(r, hi); s[q * 64 + r32] = (bf16_t)f2bf(acc[0][r]); s[q * 64 + 32 + r32] = (bf16_t)f2bf(acc[1][r]); }
    asm volatile("s_waitcnt lgkmcnt(0)" ::: "memory");
#pragma unroll
    for (int i = 0; i < 4; ++i) { const int q = i * 8 + (lane >> 3), ch = lane & 7; const u32x4 v = *(const LAS u32x4*)(stg + q * 128 + ch * 16); *(u32x4*)(dst + ro(q) + ch * 8) = v; }
    asm volatile("s_waitcnt lgkmcnt(0)" ::: "memory");
}
struct RowOffNsa { size_t base; __device__ __forceinline__ size_t operator()(int q) const { return base + (size_t)(q >> 2) * DM + (q & 3) * 64; } };
struct RowOffTok { size_t base; __device__ __forceinline__ size_t operator()(int q) const { return base + (size_t)q * DM; } };

__device__ __forceinline__ void build_tabd(LAS unsigned char* lds, const float* __restrict__ rel, int tid) {
    LAS float* tabd = (LAS float*)(lds + L_TABD);
    for (int i = tid; i < 8 * 128; i += NTHR) tabd[i] = rel[(i >> 7) * 32 + rel_bucket(i & 127)] * LOG2E;
    __syncthreads();
}

#define ATT_TILE_LOOP(nt, Kp, Vp, PITCH, WITHV, ROW, COMPUTE) do { \
    const int nt_ = (nt); constexpr int NI_ = (WITHV) ? 2 : 1; const unsigned ring_ = (unsigned)(uintptr_t)(lds + L_KV); \
    if (nt_ > 0) { \
      kv_dma<WITHV>((Kp), (Vp), ROW(0), (PITCH), ring_); \
      if (nt_ > 1) kv_dma<WITHV>((Kp), (Vp), ROW(1), (PITCH), ring_ + KVBUF); \
      if (nt_ > 2) kv_dma<WITHV>((Kp), (Vp), ROW(2), (PITCH), ring_ + 2 * KVBUF); \
      wait_tiles(NI_ * ((nt_ > 3 ? 3 : nt_) - 1)); \
      for (int it = 0; it < nt_; ++it) { \
        if (it + 3 < nt_) kv_dma<WITHV>((Kp), (Vp), ROW(it + 3), (PITCH), ring_ + ((it + 3) & 3) * KVBUF); \
        LAS unsigned char* cur_ = lds + L_KV + (it & 3) * KVBUF; \
        { COMPUTE(it, cur_); } \
        { const int last_ = (it + 3 < nt_) ? it + 3 : nt_ - 1; const int fly_ = last_ - (it + 1); wait_tiles(fly_ > 0 ? NI_ * fly_ : 0); } } } } while (0)

__device__ __forceinline__ void nsa_block(LAS unsigned char* lds, const bf16_t* Hb, const bf16_t* KCb, const bf16_t* VCb, bf16_t* MIXb, int blk) {
    const int tid = fresh_tid(), lane = tid & 63, r32 = lane & 31, hi = lane >> 5, wid = __builtin_amdgcn_readfirstlane(tid >> 6);
    const int tl = r32 >> 2, h = r32 & 3, tokw = blk * 64 + wid * 8, t = tokw + tl;
    LAS float* wsf = (LAS float*)(lds + L_WSF) + wid * 64;
    const LAS float* tabdh = (const LAS float*)(lds + L_TABD) + h * 128;
    LAS float* imp = (LAS float*)(lds + L_IMP);
    LAS unsigned* selb = (LAS unsigned*)(lds + L_SEL);
    const float tabc = tabdh[127];
    const bf16_t* hrow = Hb + (size_t)t * HP;
    bf16x8 qr[4];
#pragma unroll
    for (int d0 = 0; d0 < 4; ++d0) qr[d0] = *(const bf16x8*)(hrow + LayB::QN + h * 64 + d0 * 16 + hi * 8);
    const float g0 = sigmoidf_(bf2f(hrow[LayB::GN + h * 3 + 0])), g1 = sigmoidf_(bf2f(hrow[LayB::GN + h * 3 + 1])), g2 = sigmoidf_(bf2f(hrow[LayB::GN + h * 3 + 2]));
    for (int i = tid; i < 64 * 129; i += NTHR) imp[i] = 0.f;
    if (tid < 256) selb[tid] = 0u;
    const f32x16 z16 = {0.f, 0.f, 0.f, 0.f, 0.f, 0.f, 0.f, 0.f, 0.f, 0.f, 0.f, 0.f, 0.f, 0.f, 0.f, 0.f};
    unsigned accp[2][8]; f32x16 o[2];
#pragma unroll
    for (int i = 0; i < 8; ++i) { accp[0][i] = 0u; accp[1][i] = 0u; }
    float m, l;
    __syncthreads();

    const int tmax = blk * 64 + 63, cntmax = tmax >= 31 ? (tmax - 31) / 16 + 1 : 0, ntc = (cntmax + 63) >> 6;
    const int Dc = t - 31;
    const int twmin = tokw;
#define ROWC(i) ((i) * 64)
    m = M_INIT; l = 0.f;
#define CMP1(it, kv) do { f32x16 p0, p1; qk_tile(p0, p1, kv, qr, r32, hi); const int n0 = (it) * 64; \
        if (twmin - 31 - 16 * (n0 + 63) >= 128) bias_far(p0, p1, tabc); else bias_near<16, (1 << 30)>(p0, p1, Dc - 16 * n0, tabdh, true, hi); \
        const float rm = rowmax32(p0, p1), mn = fmaxf(m, rm); l *= __builtin_amdgcn_exp2f(m - mn); m = mn; float s_ = 0.f; \
        _Pragma("unroll") for (int r = 0; r < 16; ++r) s_ += __builtin_amdgcn_exp2f(p0[r] - m) + __builtin_amdgcn_exp2f(p1[r] - m); l += s_; } while (0)
    ATT_TILE_LOOP(ntc, KCb, VCb, 64, false, ROWC, CMP1);
    {
        const float lt = swapsum(l), inv = lt > 0.f ? 1.0f / lt : 0.f;
        o[0] = z16; o[1] = z16;
#define CMP2(it, kv) do { f32x16 p0, p1; qk_tile(p0, p1, kv, qr, r32, hi); const int n0 = (it) * 64; \
        if (twmin - 31 - 16 * (n0 + 63) >= 128) bias_far(p0, p1, tabc); else bias_near<16, (1 << 30)>(p0, p1, Dc - 16 * n0, tabdh, true, hi); \
        _Pragma("unroll") for (int r = 0; r < 16; ++r) { p0[r] = __builtin_amdgcn_exp2f(p0[r] - m) * inv; p1[r] = __builtin_amdgcn_exp2f(p1[r] - m) * inv; } \
        _Pragma("unroll") for (int g = 0; g < 4; ++g) { \
            float a0 = (p0[4 * g] + p0[4 * g + 1]) + (p0[4 * g + 2] + 0.5f * p0[4 * g + 3]), b0 = 0.5f * p0[4 * g + 3]; \
            float a1 = (p1[4 * g] + p1[4 * g + 1]) + (p1[4 * g + 2] + 0.5f * p1[4 * g + 3]), b1 = 0.5f * p1[4 * g + 3]; \
            a0 += __shfl_xor(a0, 1); b0 += __shfl_xor(b0, 1); a1 += __shfl_xor(a1, 1); b1 += __shfl_xor(b1, 1); \
            a0 += __shfl_xor(a0, 2); b0 += __shfl_xor(b0, 2); a1 += __shfl_xor(a1, 2); b1 += __shfl_xor(b1, 2); \
            if (h == 0) { const int j0 = (n0 >> 2) + 2 * g + hi; float* ip = (float*)(imp + (wid * 8 + tl) * 129 + j0); \
                atomicAdd(ip, a0); atomicAdd(ip + 1, b0); atomicAdd(ip + 8, a1); atomicAdd(ip + 9, b1); } } \
        pv_tile(o, kv + 8192, p0, p1, lane, hi); } while (0)
        ATT_TILE_LOOP(ntc, KCb, VCb, 64, true, ROWC, CMP2);
        axpy_rows(accp, o, g0, wsf, r32, hi);
    }
    __syncthreads();
    {
        const int tok = tid >> 3, part = tid & 7;
        const LAS float* ir = imp + tok * 129;
        const int nf = blk >= 2 ? 3 : blk + 1, nc = blk >= 2 ? blk - 2 : 0, K = 16 - nf;
        unsigned uv[16]; unsigned vm = 0u, fb = 0u;
#pragma unroll
        for (int jj = 0; jj < 16; ++jj) { const int j = part * 16 + jj; const bool cand = (j >= 1) && (j <= blk - 2);
            uv[jj] = cand ? __float_as_uint(ir[j]) : 0u; vm |= cand ? (1u << jj) : 0u;
            fb |= ((j <= blk) && ((j == 0) || (j == blk) || (j == blk - 1))) ? (1u << jj) : 0u; }
        unsigned bits;
        if (nc <= K) bits = vm;
        else {
            unsigned T = 0u;
            for (int bit = 30; bit >= 0; --bit) {
                const unsigned cand = T | (1u << bit); int c = 0;
#pragma unroll
                for (int jj = 0; jj < 16; ++jj) c += (uv[jj] >= cand) ? 1 : 0;
                c += __shfl_xor(c, 1); c += __shfl_xor(c, 2); c += __shfl_xor(c, 4);
                if (c >= K) T = cand;
            }
            unsigned gtb = 0u, eqb = 0u;
#pragma unroll
            for (int jj = 0; jj < 16; ++jj) { gtb |= (uv[jj] > T) ? (1u << jj) : 0u; eqb |= (((vm >> jj) & 1u) && uv[jj] == T) ? (1u << jj) : 0u; }
            int gt = __builtin_popcount(gtb); gt += __shfl_xor(gt, 1); gt += __shfl_xor(gt, 2); gt += __shfl_xor(gt, 4);
            const int need = K - gt;
            const int mine = __builtin_popcount(eqb); int incl = mine;
            { int t_; t_ = __shfl_up(incl, 1, 8); if (part >= 1) incl += t_; t_ = __shfl_up(incl, 2, 8); if (part >= 2) incl += t_; t_ = __shfl_up(incl, 4, 8); if (part >= 4) incl += t_; }
            int before = incl - mine;
            bits = gtb;
#pragma unroll
            for (int jj = 0; jj < 16; ++jj) { if ((eqb >> jj) & 1u) { if (before < need) bits |= 1u << jj; ++before; } }
        }
        bits |= fb;
        atomicOr((unsigned*)(selb + tok * 4 + (part >> 1)), bits << ((part & 1) * 16));
    }
    __syncthreads();
    unsigned sm[4];
#pragma unroll
    for (int i = 0; i < 4; ++i) sm[i] = selb[(wid * 8 + tl) * 4 + i];
    const int Ds = t;
    m = M_INIT; l = 0.f; o[0] = z16; o[1] = z16;
#define ROWS(i) ((i) * 64)
#define SELT(it, kv) do { const int j = (it); const unsigned w_ = j < 32 ? sm[0] : (j < 64 ? sm[1] : (j < 96 ? sm[2] : sm[3])); const bool bit = (w_ >> (j & 31)) & 1u; \
        if (__any(bit)) { f32x16 p0, p1; qk_tile(p0, p1, kv, qr, r32, hi); \
            if (twmin - (j * 64 + 63) >= 128) bias_far(p0, p1, bit ? tabc : NEG_INF); else bias_near<1, (1 << 30)>(p0, p1, Ds - j * 64, tabdh, bit, hi); \
            osm_update(p0, p1, m, l, o, wsf, r32, hi); pv_tile(o, kv + 8192, p0, p1, lane, hi); } } while (0)
    ATT_TILE_LOOP(blk + 1, Hb + LayB::KS, Hb + LayB::VS, HP, true, ROWS, SELT);
    { const float lt = swapsum(l), inv = lt > 0.f ? 1.0f / lt : 0.f; axpy_rows(accp, o, g1 * inv, wsf, r32, hi); }
    const int jw0 = blk >= 8 ? blk - 8 : 0;
    m = M_INIT; l = 0.f; o[0] = z16; o[1] = z16;
#define ROWW(i) ((jw0 + (i)) * 64)
#define WINT(it, kv) do { const int j = jw0 + (it); f32x16 p0, p1; qk_tile(p0, p1, kv, qr, r32, hi); \
        if (twmin - (j * 64 + 63) >= 128 && (tokw + 7) - j * 64 < 512) bias_far(p0, p1, tabc); else bias_near<1, 512>(p0, p1, Ds - j * 64, tabdh, true, hi); \
        osm_update(p0, p1, m, l, o, wsf, r32, hi); pv_tile(o, kv + 8192, p0, p1, lane, hi); } while (0)
    ATT_TILE_LOOP(blk - jw0 + 1, Hb + LayB::KW, Hb + LayB::VW, HP, true, ROWW, WINT);
    { const float lt = swapsum(l), inv = lt > 0.f ? 1.0f / lt : 0.f; axpy_rows(accp, o, g2 * inv, wsf, r32, hi); }
    {
#pragma unroll
        for (int d = 0; d < 2; ++d)
#pragma unroll
            for (int i = 0; i < 8; ++i) { o[d][2 * i] = QLO(accp[d][i]); o[d][2 * i + 1] = QHI(accp[d][i]); }
        const RowOffNsa ro{(size_t)tokw * DM}; store_cols(o, lds + L_OST + wid * 4096, MIXb, ro, lane, r32, hi); }
    __syncthreads();
#undef ROWC
#undef CMP1
#undef CMP2
#undef ROWS
#undef SELT
#undef ROWW
#undef WINT
}

__device__ __forceinline__ void moba_block(LAS unsigned char* lds, const bf16_t* Hb, const float* __restrict__ KMh, bf16_t* MIXb, int hd, int own) {
    const int tid = fresh_tid(), lane = tid & 63, r32 = lane & 31, hi = lane >> 5, wid = __builtin_amdgcn_readfirstlane(tid >> 6);
    LAS float* wsf = (LAS float*)(lds + L_WSF) + wid * 64;
    const LAS float* tabdh = (const LAS float*)(lds + L_TABD) + (4 + hd) * 128;
    LAS float* kml = (LAS float*)(lds + L_IMP);
    LAS unsigned* selb = (LAS unsigned*)(lds + L_SEL);
    const float tabc = tabdh[127];
    for (int i = tid; i < 32 * 64; i += NTHR) kml[i] = KMh[i];
    __syncthreads();
    if (tid < 256) {
        const int tg = own * 256 + tid;
        unsigned q[32];
        load_qp(q, Hb + (size_t)tg * HP + LayB::QM + hd * 64);
        float v0 = -BIGF, v1 = -BIGF, v2 = -BIGF; int i0 = -1, i1 = -1, i2 = -1;
        for (int j = 0; j < own; ++j) {
            const LAS float* kr = kml + j * 64; float s0 = 0.f, s1 = 0.f;
#pragma unroll
            for (int c = 0; c < 16; ++c) { const f32x4_t w = *(const LAS f32x4_t*)(kr + 4 * c);
                s0 = fmaf(QLO(q[2 * c]), w[0], s0); s1 = fmaf(QHI(q[2 * c]), w[1], s1); s0 = fmaf(QLO(q[2 * c + 1]), w[2], s0); s1 = fmaf(QHI(q[2 * c + 1]), w[3], s1); }
            const float g = s0 + s1;
            if (g > v0) { v2 = v1; i2 = i1; v1 = v0; i1 = i0; v0 = g; i0 = j; }
            else if (g > v1) { v2 = v1; i2 = i1; v1 = g; i1 = j; }
            else if (g > v2) { v2 = g; i2 = j; }
        }
        unsigned mk = 0u;
        if (i0 >= 0) mk |= 1u << i0;
        if (i1 >= 0) mk |= 1u << i1;
        if (i2 >= 0) mk |= 1u << i2;
        selb[tid] = mk;
    }
    __syncthreads();
    const int tokw = own * 256 + wid * 32, t = tokw + r32;
    const unsigned mk = selb[wid * 32 + r32];
    bf16x8 qr[4];
#pragma unroll
    for (int d0 = 0; d0 < 4; ++d0) qr[d0] = *(const bf16x8*)(Hb + (size_t)t * HP + LayB::QM + hd * 64 + d0 * 16 + hi * 8);
    const f32x16 z16 = {0.f, 0.f, 0.f, 0.f, 0.f, 0.f, 0.f, 0.f, 0.f, 0.f, 0.f, 0.f, 0.f, 0.f, 0.f, 0.f};
    f32x16 o[2] = {z16, z16};
    float m = M_INIT, l = 0.f;
    const int nt = own * 4 + 4;
#define ROWM(i) ((i) * 64)
#define MOBT(it, kv) do { const int pos0 = (it) * 64; const bool past = (it) < own * 4; const bool bit = past ? ((mk >> ((it) >> 2)) & 1u) : true; \
        const bool need = past ? __any(bit) : (pos0 <= tokw + 31); \
        if (need) { f32x16 p0, p1; qk_tile(p0, p1, kv, qr, r32, hi); \
            if (tokw - (pos0 + 63) >= 128) bias_far(p0, p1, bit ? tabc : NEG_INF); else bias_near<1, (1 << 30)>(p0, p1, t - pos0, tabdh, bit, hi); \
            osm_update(p0, p1, m, l, o, wsf, r32, hi); pv_tile(o, kv + 8192, p0, p1, lane, hi); } } while (0)
    ATT_TILE_LOOP(nt, Hb + LayB::KM + hd * 64, Hb + LayB::VM + hd * 64, HP, true, ROWM, MOBT);
    { const float lt = swapsum(l), inv = lt > 0.f ? 1.0f / lt : 0.f; scale_rows(o, inv, wsf, r32, hi); }
    { const RowOffTok ro{(size_t)tokw * DM + 256 + hd * 64}; store_cols(o, lds + L_OST + wid * 4096, MIXb, ro, lane, r32, hi); }
    __syncthreads();
#undef ROWM
#undef MOBT
}
}

template <class L>
__device__ __forceinline__ void cmp_unit(LAS unsigned char* lds, const bf16_t* __restrict__ H, const float* __restrict__ pe, const bf16_t* __restrict__ W1T, const float* __restrict__ b1,
                                         const float* __restrict__ w2, bf16_t* KCV, int unit) {
    typedef short bf16x8v __attribute__((ext_vector_type(8)));
    typedef float f32x16v __attribute__((ext_vector_type(16)));
    const int tid = fresh_tid(), lane = tid & 63, r32 = lane & 31, hi = lane >> 5, wv = __builtin_amdgcn_readfirstlane(tid >> 6);
    const int which = unit >> 6, b = (unit >> 4) & 3, n0 = (unit & 15) * 32;
    LAS float* hid = (LAS float*)lds;
    for (int i = tid; i < 256 * 32; i += NTHR) hid[i] = 0.f;
    __syncthreads();
    {
        const int n = n0 + r32 < NCMP ? n0 + r32 : NCMP - 1;
        const bf16_t* krow = H + (size_t)(b * S_ + n * 16) * L::P + L::KC + which * 64;
        const float* pew = pe + which * 2048;
        const bf16_t* wrow = W1T + (size_t)which * 256 * 2048 + (size_t)r32 * 2048;
        const f32x16v z = {0.f, 0.f, 0.f, 0.f, 0.f, 0.f, 0.f, 0.f, 0.f, 0.f, 0.f, 0.f, 0.f, 0.f, 0.f, 0.f};
        f32x16v acc[8] = {z, z, z, z, z, z, z, z};
#pragma unroll 2
        for (int ks = 0; ks < 16; ++ks) {
            const int p = wv * 4 + (ks >> 2), dc = ks & 3, kk = p * 64 + dc * 16 + hi * 8;
            const uint4 kraw = *(const uint4*)(krow + (size_t)p * L::P + dc * 16 + hi * 8);
            const float4 pa = *(const float4*)(pew + kk), pb = *(const float4*)(pew + kk + 4);
            typedef unsigned u32x4v __attribute__((ext_vector_type(4)));
            const u32x4v bw = {pk2(QLO(kraw.x) + pa.x, QHI(kraw.x) + pa.y), pk2(QLO(kraw.y) + pa.z, QHI(kraw.y) + pa.w), pk2(QLO(kraw.z) + pb.x, QHI(kraw.z) + pb.y), pk2(QLO(kraw.w) + pb.z, QHI(kraw.w) + pb.w)};
            const bf16x8v bf = __builtin_bit_cast(bf16x8v, bw);
#pragma unroll
            for (int jt = 0; jt < 8; ++jt) { const bf16x8v af = *(const bf16x8v*)(wrow + (size_t)jt * 32 * 2048 + kk); acc[jt] = __builtin_amdgcn_mfma_f32_32x32x16_bf16(af, bf, acc[jt], 0, 0, 0); }
        }
#pragma unroll
        for (int jt = 0; jt < 8; ++jt)
#pragma unroll
            for (int r = 0; r < 16; ++r) atomicAdd((float*)(hid + (jt * 32 + (r & 3) + 8 * (r >> 2) + 4 * hi) * 32 + r32), acc[jt][r]);
    }
    __syncthreads();
    for (int i = tid; i < 256 * 32; i += NTHR) { const float a = hid[i] + b1[which * 256 + (i >> 5)]; hid[i] = 0.5f * a * (1.0f + tanhf(0.7978845608028654f * (a + 0.044715f * a * a * a))); }
    __syncthreads();
    {
        const int d = tid & 63, ng = tid >> 6;
        float o[4] = {0.f, 0.f, 0.f, 0.f};
        const float* w2p = w2 + (size_t)which * 256 * 64 + d;
#pragma unroll 8
        for (int j = 0; j < 256; ++j) { const float wj = w2p[j * 64]; const f32x4_t hv = *(const LAS f32x4_t*)(hid + j * 32 + ng * 4);
#pragma unroll
            for (int r = 0; r < 4; ++r) o[r] = fmaf(hv[r], wj, o[r]); }
#pragma unroll
        for (int r = 0; r < 4; ++r) { const int n = n0 + ng * 4 + r; KCV[(((size_t)which * B_ + b) * 512 + n) * 64 + d] = (bf16_t)f2bf(n < NCMP ? o[r] : 0.f); }
    }
    __syncthreads();
}
template <class L>
__device__ __forceinline__ void kmean_unit(LAS unsigned char* lds, const typename L::T* H, float* KM, int unit) {
    const int tid = fresh_tid(), b = unit >> 7, h = (unit >> 5) & 3, j = unit & 31, d = tid & 63, g = tid >> 6;
    LAS float* part = (LAS float*)lds;
    const typename L::T* src = H + (size_t)(b * S_ + j * 256) * L::P + L::KM + h * 64 + d;
    float s = 0.f;
    for (int r = g; r < 256; r += 8) s += ldf(src + (size_t)r * L::P);
    part[g * 64 + d] = s;
    __syncthreads();
    if (tid < 64) { float t = 0.f;
#pragma unroll
        for (int gg = 0; gg < 8; ++gg) t += part[gg * 64 + tid];
        KM[((size_t)(b * 4 + h) * 32 + j) * 64 + tid] = t * (1.0f / 256.0f); }
    __syncthreads();
}
template <class L>
__device__ __forceinline__ void conv_unit(LAS unsigned char* lds, const bf16_t* __restrict__ H, const float* __restrict__ wdw, const float* __restrict__ bdw, const float* __restrict__ lng,
                                          const float* __restrict__ lnb, const bf16_t* __restrict__ WPT, bf16_t* __restrict__ MIX, int unit) {
    typedef short bf16x8v __attribute__((ext_vector_type(8)));
    typedef float f32x16v __attribute__((ext_vector_type(16)));
    const int tid = fresh_tid(), g0 = unit * 64, tb = g0 & (S_ - 1);
    LAS bf16_t* HsB = (LAS bf16_t*)lds;
    LAS float* Ys = (LAS float*)(lds + 49152);
    LAS unsigned char* Ab = lds;
    for (int q = tid; q < 94 * 32; q += NTHR) {
        const int r = q >> 5, c8 = q & 31, dt = r - 30;
        typedef unsigned u32x4v __attribute__((ext_vector_type(4)));
        u32x4v o = {0u, 0u, 0u, 0u};
        if (tb + dt >= 0) {
            const bf16_t* hr = H + (size_t)(g0 + dt) * L::P + L::CV + c8 * 8;
            const uint4 a = *(const uint4*)hr, g = *(const uint4*)(hr + 256);
            const unsigned av[4] = {a.x, a.y, a.z, a.w}, gv[4] = {g.x, g.y, g.z, g.w}; unsigned ov[4];
#pragma unroll
            for (int i = 0; i < 4; ++i) ov[i] = pk2(QLO(av[i]) * sigmoidf_(QLO(gv[i])), QHI(av[i]) * sigmoidf_(QHI(gv[i])));
            o = (u32x4v){ov[0], ov[1], ov[2], ov[3]};
        }
        *(LAS u32x4v*)(HsB + r * 256 + c8 * 8) = o;
    }
    __syncthreads();
    {
        const int cp = tid & 127, tg = tid >> 7;
        float w0[31], w1[31];
#pragma unroll
        for (int k = 0; k < 31; ++k) { const float2 wv = *(const float2*)(wdw + k * 256 + 2 * cp); w0[k] = wv.x; w1[k] = wv.y; }
        const float2 bb = *(const float2*)(bdw + 2 * cp);
        float a0[16], a1[16];
#pragma unroll
        for (int i = 0; i < 16; ++i) { a0[i] = bb.x; a1[i] = bb.y; }
#pragma unroll
        for (int rr = 0; rr < 46; ++rr) {
            const unsigned hv = *(const LAS unsigned*)(HsB + (16 * tg + rr) * 256 + 2 * cp);
            const float h0 = QLO(hv), h1 = QHI(hv);
#pragma unroll
            for (int i = 0; i < 16; ++i) { const int k = rr - i; if (k >= 0 && k <= 30) { a0[i] = fmaf(h0, w0[k], a0[i]); a1[i] = fmaf(h1, w1[k], a1[i]); } }
        }
#pragma unroll
        for (int i = 0; i < 16; ++i) { typedef float f32x2v __attribute__((ext_vector_type(2))); *(LAS f32x2v*)(Ys + (16 * tg + i) * 256 + 2 * cp) = (f32x2v){a0[i], a1[i]}; }
    }
    __syncthreads();
    {
        const int wv = __builtin_amdgcn_readfirstlane(tid >> 6), lane = tid & 63;
        const f32x4_t gg = *(const f32x4_t*)(lng + 4 * lane), bt = *(const f32x4_t*)(lnb + 4 * lane);
#pragma unroll
        for (int i = 0; i < 8; ++i) {
            const int tk = wv * 8 + i;
            f32x4_t v = *(const LAS f32x4_t*)(Ys + tk * 256 + 4 * lane);
            float s = (v[0] + v[1]) + (v[2] + v[3]);
#pragma unroll
            for (int o = 1; o < 64; o <<= 1) s += __shfl_xor(s, o);
            const float mu = s * (1.0f / 256.0f);
            v = v - mu;
            float s2 = (v[0] * v[0] + v[1] * v[1]) + (v[2] * v[2] + v[3] * v[3]);
#pragma unroll
            for (int o = 1; o < 64; o <<= 1) s2 += __shfl_xor(s2, o);
            const float rstd = 1.0f / sqrtf(s2 * (1.0f / 256.0f) + 1e-5f);
            f32x4_t y = v * rstd * gg + bt;
#pragma unroll
            for (int e = 0; e < 4; ++e) y[e] = y[e] * sigmoidf_(y[e]);
            typedef unsigned u32x2v __attribute__((ext_vector_type(2)));
            *(LAS u32x2v*)(Ab + tk * 512 + (((lane >> 1) ^ (tk & 31)) * 16) + (lane & 1) * 8) = (u32x2v){pk2(y[0], y[1]), pk2(y[2], y[3])};
        }
    }
    __syncthreads();
    {
        const int wv = __builtin_amdgcn_readfirstlane(tid >> 6), lane = tid & 63, r32 = lane & 31, hi = lane >> 5, n0 = wv * 32;
        bf16x8v af[16];
#pragma unroll
        for (int ks = 0; ks < 16; ++ks) af[ks] = *(const bf16x8v*)(WPT + (size_t)(n0 + r32) * 256 + ks * 16 + hi * 8);
        const f32x16v z = {0.f, 0.f, 0.f, 0.f, 0.f, 0.f, 0.f, 0.f, 0.f, 0.f, 0.f, 0.f, 0.f, 0.f, 0.f, 0.f};
        f32x16v c0 = z, c1 = z;
#pragma unroll
        for (int ks = 0; ks < 16; ++ks) {
            const int ph = ((2 * ks + hi) ^ r32) * 16;
            const bf16x8v b0 = *(const LAS bf16x8v*)(Ab + r32 * 512 + ph), b1 = *(const LAS bf16x8v*)(Ab + (32 + r32) * 512 + ph);
            c0 = __builtin_amdgcn_mfma_f32_32x32x16_bf16(af[ks], b0, c0, 0, 0, 0);
            c1 = __builtin_amdgcn_mfma_f32_32x32x16_bf16(af[ks], b1, c1, 0, 0, 0);
        }
        typedef unsigned u32x2v __attribute__((ext_vector_type(2)));
#pragma unroll
        for (int g = 0; g < 4; ++g) {
            bf16_t* d0 = MIX + (size_t)(g0 + r32) * DM + 512 + n0 + 8 * g + 4 * hi;
            *(u32x2v*)d0 = (u32x2v){pk2(c0[4 * g], c0[4 * g + 1]), pk2(c0[4 * g + 2], c0[4 * g + 3])};
            *(u32x2v*)(d0 + (size_t)32 * DM) = (u32x2v){pk2(c1[4 * g], c1[4 * g + 1]), pk2(c1[4 * g + 2], c1[4 * g + 3])};
        }
    }
    __syncthreads();
}
template <class L>
__device__ __forceinline__ void hgrn1_unit(LAS unsigned char* lds, const bf16_t* __restrict__ H, const float* __restrict__ lb, float* __restrict__ OL, float* __restrict__ QP, float* __restrict__ U, float* __restrict__ Dg, int unit) {
    const int tid = fresh_tid(), v = tid & 63, kg = tid >> 6, k0 = kg * 8, b = unit >> 6, h = (unit >> 4) & 3, seg = unit & 15;
    LAS float* Fl = (LAS float*)lds; LAS float* Ql = Fl + HT * 64; LAS float* Vl = Ql + HT * 64; LAS float* QPl = Vl + HT * 64; LAS float* Op = QPl + HT * 64;
    static_assert(HT == 32, "piece mapping below assumes 32-token chunks");
    const int c8 = tid & 7, prow = (tid & 255) >> 3, parr = tid >> 8;
    const size_t colA = (parr == 0 ? L::FH : L::QH) + h * 64 + c8 * 8, colB = L::IH + h * 64 + c8 * 8;
    float lb8[8];
#pragma unroll
    for (int e = 0; e < 8; ++e) lb8[e] = lb[h * 64 + c8 * 8 + e];
    const size_t tb0 = (size_t)b * S_ + seg * HSEG;
    uint4 ra = *(const uint4*)(H + (tb0 + prow) * L::P + colA), rb = make_uint4(0u, 0u, 0u, 0u);
    if (tid < 256) rb = *(const uint4*)(H + (tb0 + prow) * L::P + colB);
    float s[8];
#pragma unroll
    for (int i = 0; i < 8; ++i) s[i] = 0.f;
    float P = 1.0f;
    for (int c = 0; c < HSEG / HT; ++c) {
        const size_t tb = tb0 + c * HT;
        {
            const unsigned wa[4] = {ra.x, ra.y, ra.z, ra.w};
            float va[8];
#pragma unroll
            for (int i = 0; i < 4; ++i) { va[2 * i] = QLO(wa[i]); va[2 * i + 1] = QHI(wa[i]); }
            if (parr == 0) {
#pragma unroll
                for (int e = 0; e < 8; ++e) va[e] = lb8[e] + (1.0f - lb8[e]) * sigmoidf_(va[e]);
            }
            LAS float* dst = (parr == 0 ? Fl : Ql) + prow * 64 + c8 * 8;
            *(LAS f32x4_t*)dst = (f32x4_t){va[0], va[1], va[2], va[3]}; *(LAS f32x4_t*)(dst + 4) = (f32x4_t){va[4], va[5], va[6], va[7]};
            if (tid < 256) { const unsigned wb[4] = {rb.x, rb.y, rb.z, rb.w}; LAS float* dv = Vl + prow * 64 + c8 * 8;
                *(LAS f32x4_t*)dv = (f32x4_t){QLO(wb[0]), QHI(wb[0]), QLO(wb[1]), QHI(wb[1])}; *(LAS f32x4_t*)(dv + 4) = (f32x4_t){QLO(wb[2]), QHI(wb[2]), QLO(wb[3]), QHI(wb[3])}; }
        }
        __syncthreads();
        if (c + 1 < HSEG / HT) {
            ra = *(const uint4*)(H + (tb + HT + prow) * L::P + colA);
            if (tid < 256) rb = *(const uint4*)(H + (tb + HT + prow) * L::P + colB);
        }
        for (int tt = 0; tt < HT; ++tt) {
            if (v < 8) { P *= Fl[tt * 64 + k0 + v]; QPl[tt * 64 + k0 + v] = Ql[tt * 64 + k0 + v] * P; }
            const float vv = Vl[tt * 64 + v];
            const f32x4_t fa = *(const LAS f32x4_t*)&Fl[tt * 64 + k0], fb = *(const LAS f32x4_t*)&Fl[tt * 64 + k0 + 4];
            const f32x4_t qa = *(const LAS f32x4_t*)&Ql[tt * 64 + k0], qb = *(const LAS f32x4_t*)&Ql[tt * 64 + k0 + 4];
            const float f[8] = {fa.x, fa.y, fa.z, fa.w, fb.x, fb.y, fb.z, fb.w}, q[8] = {qa.x, qa.y, qa.z, qa.w, qb.x, qb.y, qb.z, qb.w};
            float o0 = 0.f, o1 = 0.f;
#pragma unroll
            for (int i = 0; i < 8; i += 2) {
                s[i] = fmaf(f[i], s[i], (1.0f - f[i]) * vv); o0 = fmaf(q[i], s[i], o0);
                s[i + 1] = fmaf(f[i + 1], s[i + 1], (1.0f - f[i + 1]) * vv); o1 = fmaf(q[i + 1], s[i + 1], o1);
            }
            Op[(kg * HT + tt) * 64 + v] = o0 + o1;
        }
        __syncthreads();
        for (int idx = tid; idx < HT * 64; idx += NTHR) {
            const int tt = idx >> 6, cc = idx & 63;
            float o = 0.f;
#pragma unroll
            for (int g = 0; g < 8; ++g) o += Op[(g * HT + tt) * 64 + cc];
            OL[(tb + tt) * 256 + h * 64 + cc] = o;
            QP[(tb + tt) * 256 + h * 64 + cc] = QPl[idx];
        }
        __syncthreads();
    }
    float* Uu = U + (size_t)unit * 4096;
#pragma unroll
    for (int i = 0; i < 8; ++i) Uu[(k0 + i) * 64 + v] = s[i];
    if (v < 8) Dg[unit * 64 + k0 + v] = P;
}
template <class L>
__device__ __forceinline__ void hgrn2_unit(const bf16_t* __restrict__ H, const float* __restrict__ OL, const float* __restrict__ QP, const float* __restrict__ U, const float* __restrict__ Dg,
                                           const float* __restrict__ ng, bf16_t* __restrict__ MIX, int unit) {
    const int tid = fresh_tid(), v = tid & 63, wv = __builtin_amdgcn_readfirstlane(tid >> 6), b = unit >> 6, h = (unit >> 4) & 3, seg = unit & 15;
    float Sr[64];
#pragma unroll
    for (int k = 0; k < 64; ++k) Sr[k] = 0.f;
    for (int j = 0; j < seg; ++j) {
        const float* Uu = U + (size_t)(unit - seg + j) * 4096; const float dv = Dg[(unit - seg + j) * 64 + v];
#pragma unroll
        for (int k = 0; k < 64; ++k) Sr[k] = fmaf(__uint_as_float(__builtin_amdgcn_readlane(__float_as_uint(dv), k)), Sr[k], Uu[k * 64 + v]);
    }
    const float gn = ng[h * 64 + v];
    const size_t t0 = (size_t)b * S_ + seg * HSEG + wv * 64;
    for (int i0 = 0; i0 < 64; i0 += 8) {
        float ol[8], qp[8], gg[8];
#pragma unroll
        for (int i = 0; i < 8; ++i) { const size_t t = t0 + i0 + i; ol[i] = OL[t * 256 + h * 64 + v]; qp[i] = QP[t * 256 + h * 64 + v]; gg[i] = bf2f(H[t * L::P + L::GH + h * 64 + v]); }
#pragma unroll
        for (int i = 0; i < 8; ++i) {
            float o0 = ol[i], o1 = 0.f;
#pragma unroll
            for (int k = 0; k < 64; k += 2) { o0 = fmaf(__uint_as_float(__builtin_amdgcn_readlane(__float_as_uint(qp[i]), k)), Sr[k], o0); o1 = fmaf(__uint_as_float(__builtin_amdgcn_readlane(__float_as_uint(qp[i]), k + 1)), Sr[k + 1], o1); }
            const float o = o0 + o1;
            float ss = o * o;
#pragma unroll
            for (int d = 1; d < 64; d <<= 1) ss += __shfl_xor(ss, d);
            const float r = 1.0f / sqrtf(ss * (1.0f / 64.0f) + 1e-6f);
            MIX[(t0 + i0 + i) * DM + 768 + h * 64 + v] = (bf16_t)f2bf(o * r * gn * sigmoidf_(gg[i]));
        }
    }
}

struct Frame {
    LAS unsigned char* lds; volatile LAS unsigned* MISC; unsigned* ctl;
    int tid, lane, wave, vcu, G;
};
__device__ __forceinline__ void transpose_item(const float* __restrict__ W, int K, int N, bf16_t* WT, LAS float* scr, int item, int lane, int shift_at, int shift) {
    const int nblk = (N + 31) / 32, kb = item / nblk, nb = item % nblk, k0 = 64 * kb, n0 = 32 * nb;
    const int nl = n0 + (lane & 31);
#pragma unroll 8
    for (int i = 0; i < 32; ++i) { const int kk = 2 * i + (lane >> 5); scr[kk * 33 + (lane & 31)] = nl < N ? W[(size_t)(k0 + kk) * N + nl] : 0.f; }
    asm volatile("s_waitcnt lgkmcnt(0)" ::: "memory");
    const int c = lane & 7;
#pragma unroll
    for (int j = 0; j < 4; ++j) { const int n = (lane >> 3) + 8 * j; const LAS float* s = scr + (8 * c) * 33 + n; const int ng = n0 + n;
        if (ng < N) { uint4 o; o.x = pk2(s[0 * 33], s[1 * 33]); o.y = pk2(s[2 * 33], s[3 * 33]); o.z = pk2(s[4 * 33], s[5 * 33]); o.w = pk2(s[6 * 33], s[7 * 33]);
            *(uint4*)(WT + (size_t)(ng + (ng >= shift_at ? shift : 0)) * K + k0 + 8 * c) = o; } }
    asm volatile("s_waitcnt lgkmcnt(0)" ::: "memory");
}
__device__ __forceinline__ void ln_row(const float* xrow, const float* __restrict__ g, const float* __restrict__ bta, float* orow, bf16_t* brow, int lane) {
    typedef float f32x4 __attribute__((ext_vector_type(4)));
    const f32x4* xr = (const f32x4*)xrow + lane;
    f32x4 v[4]; float s = 0.f;
#pragma unroll
    for (int j = 0; j < 4; ++j) { v[j] = xr[64 * j]; s += (v[j].x + v[j].y) + (v[j].z + v[j].w); }
#pragma unroll
    for (int o = 1; o < 64; o <<= 1) s += __shfl_xor(s, o);
    const float mean = s * (1.f / DM); float s2 = 0.f;
#pragma unroll
    for (int j = 0; j < 4; ++j) { v[j] = v[j] - mean; s2 += (v[j].x * v[j].x + v[j].y * v[j].y) + (v[j].z * v[j].z + v[j].w * v[j].w); }
#pragma unroll
    for (int o = 1; o < 64; o <<= 1) s2 += __shfl_xor(s2, o);
    const float rstd = 1.f / sqrtf(s2 * (1.f / DM) + 1e-5f);
#pragma unroll
    for (int j = 0; j < 4; ++j) { const f32x4 gg = ((const f32x4*)g)[lane + 64 * j], bb = ((const f32x4*)bta)[lane + 64 * j];
        const f32x4 y = v[j] * rstd * gg + bb;
        ((f32x4*)orow)[lane + 64 * j] = y;
        ((unsigned long long*)brow)[lane + 64 * j] = (unsigned long long)pk2(y.x, y.y) | ((unsigned long long)pk2(y.z, y.w) << 32); }
}

struct Args { const float* in[21]; float* out; unsigned char* ws; int ph_lo, ph_hi; };
constexpr int NPHASE = 1 + 8 * DEPTH;

__global__ void __launch_bounds__(NTHR, 2) mega_fwd(Args args) {
    extern __shared__ __attribute__((aligned(16))) unsigned char lds_raw[];
    Frame F;
    F.lds = (LAS unsigned char*)lds_raw;
    F.MISC = (volatile LAS unsigned*)(F.lds + MISC_OFF);
    F.tid = threadIdx.x; F.lane = F.tid & 63; F.wave = __builtin_amdgcn_readfirstlane(F.tid >> 6);
    F.G = gridDim.x; { const int bx = blockIdx.x; F.vcu = (F.G % 8 == 0) ? (bx % 8) * (F.G / 8) + bx / 8 : bx; }
    unsigned char* ws = args.ws;
    F.ctl = (unsigned*)(ws + WS_CTL);
    const float* x = args.in[0];       const float* w_in = args.in[1];
    const float* cmp_pe = args.in[2];  const float* cmp_w1 = args.in[3];  const float* cmp_b1 = args.in[4];  const float* cmp_w2 = args.in[5];
    const float* dw_w = args.in[6];    const float* dw_b = args.in[7];    const float* cln_g = args.in[8];   const float* cln_b = args.in[9];
    const float* pw_w = args.in[10];   const float* lb_logits = args.in[11]; const float* hn_g = args.in[12]; const float* w_out = args.in[13];
    const float* ln1_g = args.in[14];  const float* ln1_b = args.in[15];  const float* w_ff1 = args.in[16];  const float* w_ff2 = args.in[17];
    const float* ln2_g = args.in[18];  const float* ln2_b = args.in[19];  const float* rel = args.in[20];
    float* out = args.out;
    bf16_t* WIN = (bf16_t*)(ws + WS_WIN); bf16_t* WOUT = (bf16_t*)(ws + WS_WOUT); bf16_t* W1 = (bf16_t*)(ws + WS_W1); bf16_t* W2 = (bf16_t*)(ws + WS_W2);
    bf16_t* XB = (bf16_t*)(ws + WS_XB); bf16_t* HB = (bf16_t*)(ws + WS_H); bf16_t* MIX = (bf16_t*)(ws + WS_MIX); bf16_t* HFF = (bf16_t*)(ws + WS_HFF);
    bf16_t* KCV = (bf16_t*)(ws + WS_KCV); float* KM = (float*)(ws + WS_KM); float* OL = (float*)(ws + WS_OL); float* QP = (float*)(ws + WS_QP);
    float* U = (float*)(ws + WS_U); float* Dg = (float*)(ws + WS_DG); float* LBS = (float*)(ws + WS_LBS); bf16_t* WPT = (bf16_t*)(ws + WS_WPT); bf16_t* W1CT = (bf16_t*)(ws + WS_W1CT);

    for (int u = F.tid; u < (LDS_BYTES - LDSCTL_OFF) / 4; u += NTHR) ((LAS unsigned*)(F.lds + LDSCTL_OFF))[u] = 0u;
    __syncthreads();
    XcdBarrier bar = xcd_barrier_post((unsigned*)(F.ctl + CW_BAR), F.MISC + 8);
    const int lo = args.ph_lo, hi = args.ph_hi;
#define IN(k) (lo <= (k) && (k) < hi)
#define SEAM(k) do { if (IN(k) && IN((k) + 1)) xcd_barrier(bar); } while (0)

    if (IN(0)) {
#ifdef REP_PRO
        for (int rep_ = 0; rep_ < 2; ++rep_) {
#endif
        const int tid = fresh_tid(), lane = tid & 63, wave = __builtin_amdgcn_readfirstlane(tid >> 6);
        LAS float* scr = (LAS float*)(F.lds + wave * 16384);
        const int gw = F.vcu * NWAVES + wave, NGW = F.G * NWAVES;
        constexpr int I_IN = 16 * 93, I_OUT = 16 * 32, I_1 = 16 * 128, I_2 = 64 * 32, I_PW = 4 * 8, I_C1 = 2 * 256;
        constexpr int NITEMS = DEPTH * (I_IN + I_OUT + I_1 + I_2 + I_PW + I_C1);
        for (int it = gw; it < NITEMS; it += NGW) {
            int r = it; const int l = r / (I_IN + I_OUT + I_1 + I_2 + I_PW + I_C1); r -= l * (I_IN + I_OUT + I_1 + I_2 + I_PW + I_C1);
            if (r < I_IN) { transpose_item(w_in + (size_t)l * DM * INC, DM, INC, WIN + (size_t)l * HP * DM, scr, r, lane, SHIFT_AT, SHIFT); continue; } r -= I_IN;
            if (r < I_OUT) { transpose_item(w_out + (size_t)l * DM * DM, DM, DM, WOUT + (size_t)l * DM * DM, scr, r, lane, 1 << 30, 0); continue; } r -= I_OUT;
            if (r < I_1) { transpose_item(w_ff1 + (size_t)l * DM * FF, DM, FF, W1 + (size_t)l * FF * DM, scr, r, lane, 1 << 30, 0); continue; } r -= I_1;
            if (r < I_2) { transpose_item(w_ff2 + (size_t)l * FF * DM, FF, DM, W2 + (size_t)l * DM * FF, scr, r, lane, 1 << 30, 0); continue; } r -= I_2;
            if (r < I_PW) { transpose_item(pw_w + (size_t)l * 65536, 256, 256, WPT + (size_t)l * 65536, scr, r, lane, 1 << 30, 0); continue; } r -= I_PW;
            { const int wh = r >> 8; transpose_item(cmp_w1 + ((size_t)l * 2 + wh) * 2048 * 256, 2048, 256, W1CT + ((size_t)l * 2 + wh) * 256 * 2048, scr, r & 255, lane, 1 << 30, 0); }
        }
        for (int i = gw * 64 + lane; i < DEPTH * 116 * 128; i += NGW * 64) {
            const int l = i / (116 * 128), r = (i / 128) % 116, c = i % 128; const int row = r < 52 ? 652 + r : 3008 + (r - 52);
            *(uint4*)(WIN + ((size_t)l * HP + row) * DM + c * 8) = make_uint4(0u, 0u, 0u, 0u);
        }
        for (size_t i = (size_t)gw * 64 + lane; i < (size_t)MTOK * DM / 8; i += (size_t)NGW * 64) {
            const float4 a = ((const float4*)x)[2 * i], b = ((const float4*)x)[2 * i + 1];
            uint4 o; o.x = pk2(a.x, a.y); o.y = pk2(a.z, a.w); o.z = pk2(b.x, b.y); o.w = pk2(b.z, b.w);
            ((uint4*)XB)[i] = o;
        }
        if (blockIdx.x == 0 && tid < 256) {
            const int i = tid; const float a0 = lb_logits[i], a1 = lb_logits[256 + i], mx = fmaxf(a0, a1);
            const float e0 = expf(a0 - mx), e1 = expf(a1 - mx), p0 = e0 / (e0 + e1), p1 = e1 / (e0 + e1);
            LBS[i] = p0 - p0; LBS[256 + i] = (p0 + p1) - p0;
        }
#ifdef REP_PRO
        }
#endif
    }
    SEAM(0);

#ifdef UNROLL_L
#pragma unroll
#endif
    for (int l = 0; l < DEPTH; ++l) {
        const int pb = 1 + 8 * l;
        const float* Xin = (l == 0) ? x : out;
        if (IN(pb + 0)) {
            pg8::Gemm g{XB, WIN + (size_t)l * HP * DM, MTOK, HP, DM}; pg8::StaticOrder S; S.init(MTOK, HP, F.G, (int)blockIdx.x);
            pg8::EpiBf16<0> E{HB, HP};
            pg8::gemm_phase<pg8::EpiBf16<0>, pg8::StaticOrder, true, true>(F.lds, g, S, E);
#ifdef REP_INPROJ
            __syncthreads(); pg8::gemm_phase<pg8::EpiBf16<0>, pg8::StaticOrder, true, true>(F.lds, g, S, E);
#endif
        }
        SEAM(pb + 0);
        if (IN(pb + 1)) {
            constexpr int N_H1 = B_ * 4 * NSEG, N_CMP = 128, N_KM = B_ * 4 * 32, N_CV = MTOK / 64;
#ifdef REP_P2A
            for (int rep_ = 0; rep_ < 2; ++rep_)
#endif
            for (int u = F.vcu; u < N_H1 + N_CMP + N_KM + N_CV; u += F.G) {
                int r = u;
                #ifndef SKIP_H1
                if (r < N_H1) { hgrn1_unit<LayB>(F.lds, HB, LBS + l * 256, OL, QP, U, Dg, r);
#ifdef REP_H1
                    __syncthreads(); hgrn1_unit<LayB>(F.lds, HB, LBS + l * 256, OL, QP, U, Dg, r);
#endif
                    continue; }
#endif
                r -= N_H1;
#ifndef SKIP_CMP
                if (r < N_CMP) { cmp_unit<LayB>(F.lds, HB, cmp_pe + (size_t)l * 2 * 2048, W1CT + (size_t)l * 2 * 256 * 2048, cmp_b1 + (size_t)l * 2 * 256, cmp_w2 + (size_t)l * 2 * 256 * 64, KCV, r);
#ifdef REP_CMP
                    cmp_unit<LayB>(F.lds, HB, cmp_pe + (size_t)l * 2 * 2048, W1CT + (size_t)l * 2 * 256 * 2048, cmp_b1 + (size_t)l * 2 * 256, cmp_w2 + (size_t)l * 2 * 256 * 64, KCV, r);
#endif
                    continue; }
#endif
                r -= N_CMP;
#ifndef SKIP_KM
                if (r < N_KM) { kmean_unit<LayB>(F.lds, HB, KM, r);
#ifdef REP_KM
                    kmean_unit<LayB>(F.lds, HB, KM, r);
#endif
                    continue; }
#endif
                r -= N_KM;
#ifndef SKIP_CONV
                conv_unit<LayB>(F.lds, HB, dw_w + (size_t)l * 31 * 256, dw_b + l * 256, cln_g + l * 256, cln_b + l * 256, WPT + (size_t)l * 65536, MIX, r);
#ifdef REP_CONV
                conv_unit<LayB>(F.lds, HB, dw_w + (size_t)l * 31 * 256, dw_b + l * 256, cln_g + l * 256, cln_b + l * 256, WPT + (size_t)l * 65536, MIX, r);
#endif
#endif
            }
        }
        SEAM(pb + 1);
        if (IN(pb + 2)) {
            att::build_tabd(F.lds, rel, fresh_tid());
#ifdef REP_ATT
            for (int rep_ = 0; rep_ < 2; ++rep_)
#endif
            for (int u = F.vcu; u < 256; u += F.G) {
#ifndef SKIP_NSA
                { const int b = u >> 6, i = u & 63; const bf16_t* Hb = HB + (size_t)b * S_ * HP; bf16_t* Mb = MIX + (size_t)b * S_ * DM;
                  const bf16_t* KCb = KCV + (size_t)(0 * B_ + b) * 512 * 64; const bf16_t* VCb = KCV + (size_t)(1 * B_ + b) * 512 * 64;
                  att::nsa_block(F.lds, Hb, KCb, VCb, Mb, 127 - i);
                  att::nsa_block(F.lds, Hb, KCb, VCb, Mb, i);
#ifdef REP_NSA
                  att::nsa_block(F.lds, Hb, KCb, VCb, Mb, 127 - i);
                  att::nsa_block(F.lds, Hb, KCb, VCb, Mb, i);
#endif
                }
#endif
#ifndef SKIP_MOBA
                { const int b = u >> 6, hd = (u >> 4) & 3, k = u & 15; const bf16_t* Hb = HB + (size_t)b * S_ * HP; bf16_t* Mb = MIX + (size_t)b * S_ * DM;
                  const float* KMh = KM + (size_t)(b * 4 + hd) * 32 * 64;
                  att::moba_block(F.lds, Hb, KMh, Mb, hd, 31 - k);
                  att::moba_block(F.lds, Hb, KMh, Mb, hd, k);
#ifdef REP_MOBA
                  att::moba_block(F.lds, Hb, KMh, Mb, hd, 31 - k);
                  att::moba_block(F.lds, Hb, KMh, Mb, hd, k);
#endif
                }
#endif
#ifndef SKIP_H2
                hgrn2_unit<LayB>(HB, OL, QP, U, Dg, hn_g + l * 256, MIX, u);
#ifdef REP_H2
                hgrn2_unit<LayB>(HB, OL, QP, U, Dg, hn_g + l * 256, MIX, u);
#endif
#endif
            }
        }
        SEAM(pb + 2);
        if (IN(pb + 3)) {
            pg8::Gemm g{MIX, WOUT + (size_t)l * DM * DM, MTOK, DM, DM}; pg8::StaticOrder S; S.init(MTOK, DM, F.G, (int)blockIdx.x);
            pg8::EpiResF32 E{Xin, out, DM, ALPHA};
            pg8::gemm_phase<pg8::EpiResF32, pg8::StaticOrder, true, true>(F.lds, g, S, E);
        }
        SEAM(pb + 3);
        if (IN(pb + 4)) {
            const int tid = fresh_tid(), lane = tid & 63, wave = __builtin_amdgcn_readfirstlane(tid >> 6);
            const int gw = F.vcu * NWAVES + wave, NGW = F.G * NWAVES;
#ifdef REP_LN
            for (int m = gw; m < MTOK; m += NGW) ln_row(out + (size_t)m * DM, ln1_g + l * DM, ln1_b + l * DM, (float*)HFF + (size_t)m * DM, XB + (size_t)m * DM, lane);
#endif
            for (int m = gw; m < MTOK; m += NGW) ln_row(out + (size_t)m * DM, ln1_g + l * DM, ln1_b + l * DM, out + (size_t)m * DM, XB + (size_t)m * DM, lane);
        }
        SEAM(pb + 4);
        if (IN(pb + 5)) {
            pg8::Gemm g{XB, W1 + (size_t)l * FF * DM, MTOK, FF, DM}; pg8::StaticOrder S; S.init(MTOK, FF, F.G, (int)blockIdx.x);
            pg8::EpiBf16<2> E{HFF, FF};
            pg8::gemm_phase<pg8::EpiBf16<2>, pg8::StaticOrder, true, true>(F.lds, g, S, E);
#ifdef REP_FF1
            __syncthreads(); pg8::gemm_phase<pg8::EpiBf16<2>, pg8::StaticOrder, true, true>(F.lds, g, S, E);
#endif
        }
        SEAM(pb + 5);
        if (IN(pb + 6)) {
            pg8::Gemm g{HFF, W2 + (size_t)l * DM * FF, MTOK, DM, FF}; pg8::StaticOrder S; S.init(MTOK, DM, F.G, (int)blockIdx.x);
            pg8::EpiResF32 E{out, out, DM, ALPHA};
            pg8::gemm_phase<pg8::EpiResF32, pg8::StaticOrder, true, true>(F.lds, g, S, E);
        }
        SEAM(pb + 6);
        if (IN(pb + 7)) {
            const int tid = fresh_tid(), lane = tid & 63, wave = __builtin_amdgcn_readfirstlane(tid >> 6);
            const int gw = F.vcu * NWAVES + wave, NGW = F.G * NWAVES;
#ifdef REP_LN
            for (int m = gw; m < MTOK; m += NGW) ln_row(out + (size_t)m * DM, ln2_g + l * DM, ln2_b + l * DM, (float*)HFF + (size_t)m * DM, XB + (size_t)m * DM, lane);
#endif
            for (int m = gw; m < MTOK; m += NGW) ln_row(out + (size_t)m * DM, ln2_g + l * DM, ln2_b + l * DM, out + (size_t)m * DM, XB + (size_t)m * DM, lane);
        }
        SEAM(pb + 7);
    }
#undef IN
#undef SEAM
}

#ifndef MK_PER_PHASE
#define MK_PER_PHASE 0
#endif
extern "C" void kernel_launch(void* const* d_in, const int* in_sizes, int n_in, void* d_out, int out_size, void* d_ws, size_t ws_size, hipStream_t stream) {
    static int grid = 0;
    if (grid == 0) {
        if (n_in != 21 || out_size != MTOK * DM || ws_size < WS_END) { fprintf(stderr, "kernel_launch: unexpected problem (n_in %d out %d ws %zu)\n", n_in, out_size, ws_size); grid = -1; return; }
        int dev = 0, cus = 0, per_cu = 0;
        if (hipGetDevice(&dev) != hipSuccess || hipDeviceGetAttribute(&cus, hipDeviceAttributeMultiprocessorCount, dev) != hipSuccess) { grid = -1; return; }
        if (hipFuncSetAttribute((const void*)mega_fwd, hipFuncAttributeMaxDynamicSharedMemorySize, LDS_BYTES) != hipSuccess) { fprintf(stderr, "kernel_launch: hipFuncSetAttribute failed\n"); grid = -1; return; }
        if (hipOccupancyMaxActiveBlocksPerMultiprocessor(&per_cu, (const void*)mega_fwd, NTHR, LDS_BYTES) != hipSuccess || per_cu < 1) { fprintf(stderr, "kernel_launch: occupancy query says %d\n", per_cu); }
        (void)hipGetLastError();
        grid = cus;
    }
    if (grid < 0) return;
    (void)hipMemsetAsync((char*)d_ws + WS_CTL, 0, CTL_ZERO_BYTES, stream);
    Args a{};
    for (int i = 0; i < 21; ++i) a.in[i] = (const float*)d_in[i];
    a.out = (float*)d_out; a.ws = (unsigned char*)d_ws;
#if MK_PER_PHASE
    for (int p = 0; p < NPHASE; ++p) { a.ph_lo = p; a.ph_hi = p + 1; hipLaunchKernelGGL(mega_fwd, dim3(grid), dim3(NTHR), LDS_BYTES, stream, a); }
#else
    a.ph_lo = 0; a.ph_hi = NPHASE;
    hipLaunchKernelGGL(mega_fwd, dim3(grid), dim3(NTHR), LDS_BYTES, stream, a);
#endif
}
```

```cpp
#include <hip/hip_runtime.h>
#include <cstdio>
#include <cstdint>
#include <cmath>

constexpr int B_ = 4, S_ = 8192, DM = 1024, DEPTH = 2, MTOK = B_ * S_;
constexpr int INC = 2956, FF = 4096, NCMP = 511;
constexpr float ALPHA = 1.4142135623730951f;
constexpr float BIGF = 1e9f;
typedef unsigned short bf16_t;
typedef float f32x4_t __attribute__((ext_vector_type(4)));
#define GAS __attribute__((address_space(1)))
#define LAS __attribute__((address_space(3)))

struct LayB { typedef bf16_t T; static constexpr int P = 3072, QN = 0, KC = 256, VC = 320, KS = 384, VS = 448, KW = 512, VW = 576, GN = 640,
              QM = 768, KM = 1024, VM = 1280, CV = 1536, QH = 2048, FH = 2304, IH = 2560, GH = 2816; };
constexpr int HP = LayB::P, SHIFT_AT = 652, SHIFT = 116;

__device__ const unsigned char BUCKET_LUT[128] = {0,1,2,3,4,5,6,7,8,9,10,11,12,13,14,15,16,16,16,17,17,18,18,18,19,19,19,20,20,20,20,21,21,21,21,22,22,22,22,22,23,23,23,23,23,23,24,24,24,24,24,24,25,25,25,25,25,25,25,26,26,26,26,26,26,26,26,27,27,27,27,27,27,27,27,27,27,28,28,28,28,28,28,28,28,28,28,29,29,29,29,29,29,29,29,29,29,29,29,30,30,30,30,30,30,30,30,30,30,30,30,30,30,31,31,31,31,31,31,31,31,31,31,31,31,31,31,31};
__device__ __forceinline__ int rel_bucket(int dist) { return dist >= 128 ? 31 : (int)BUCKET_LUT[dist < 0 ? 0 : dist]; }
__device__ __forceinline__ float sigmoidf_(float x) { return 1.0f / (1.0f + expf(-x)); }
__device__ __forceinline__ float bf2f(bf16_t v) { return __uint_as_float((unsigned)v << 16); }
__device__ __forceinline__ unsigned f2bf(float f) { unsigned u = __float_as_uint(f); return (u + 0x7fffu + ((u >> 16) & 1u)) >> 16; }
__device__ __forceinline__ unsigned pk2(float lo, float hi) { return f2bf(lo) | (f2bf(hi) << 16); }
__device__ __forceinline__ float ldf(const float* p) { return *p; }
__device__ __forceinline__ float ldf(const bf16_t* p) { return bf2f(*p); }

constexpr int NWAVES = 8, NTHR = 512;
__device__ __forceinline__ int fresh_lane() { unsigned z = 0u; asm volatile("" : "+v"(z)); return (int)__builtin_amdgcn_mbcnt_hi(~0u, __builtin_amdgcn_mbcnt_lo(~0u, z)); }
__device__ __forceinline__ int fresh_tid_w(int wave) { return wave * 64 + fresh_lane(); }
__device__ __forceinline__ void load_qp(unsigned (&qp)[32], const bf16_t* p) {
#pragma unroll
    for (int c = 0; c < 8; ++c) { const uint4 w = *(const uint4*)(p + 8 * c); qp[4 * c] = w.x; qp[4 * c + 1] = w.y; qp[4 * c + 2] = w.z; qp[4 * c + 3] = w.w; }
}
#define QLO(u) __uint_as_float((u) << 16)
#define QHI(u) __uint_as_float((u) & 0xffff0000u)
namespace pg8 {
#define PG8_LAS __attribute__((address_space(3)))
typedef unsigned short bf16_t;
typedef short bf16x8 __attribute__((ext_vector_type(8)));
typedef float f32x4 __attribute__((ext_vector_type(4)));
typedef unsigned u32x4 __attribute__((ext_vector_type(4)));
constexpr int BM = 256, BK = 64, HALF = 128, HTB = HALF * BK * 2  , STAGE_BYTES = 8 * HTB, NXCD = 8, WGM = 8;

__host__ __device__ __forceinline__ int lds_byte(int r, int c) { const int st = (r >> 4) * 2 + (c >> 5), rr = r & 15, cc = c & 31, ob = rr * 64 + cc * 2; return st * 1024 + (ob ^ (((ob >> 9) & 1) << 5)); }
__host__ __device__ __forceinline__ void stage_rc(int b, int& R, int& C) { const int st = b / 1024, sb = b % 1024, swz = sb ^ (((sb >> 9) & 1) << 5); R = (st >> 1) * 16 + swz / 64; C = (st & 1) * 32 + (swz % 64) / 2; }
__host__ __device__ __forceinline__ int perm32(int rho) { const int n = rho >> 4, i = rho & 15; return 8 * (i >> 2) + 4 * n + (i & 3); }

struct Unit { int pm, pn; };
struct Gemm { const bf16_t* A; const bf16_t* Bt; int M, N, K; };

struct StaticOrder {
    int nM, nN, nwg, G, c;
    __host__ __device__ void init(int M, int N, int G_, int c_) { nM = M / BM; nN = N / BM; nwg = nM * nN; G = G_; c = c_; }
    __host__ __device__ bool next(int i, Unit& u) const {
        const long L = (long)i * G + c; if (L >= nwg) return false;
        int wgid = (int)L; { const int q = nwg / NXCD, r = nwg % NXCD, xcd = wgid % NXCD, off = wgid / NXCD; wgid = (xcd < r ? xcd * (q + 1) : r * (q + 1) + (xcd - r) * q) + off; }
        const int nig = WGM * nN, gid = wgid / nig, fm = gid * WGM, gsz = (nM - fm) < WGM ? (nM - fm) : WGM;
        u.pm = fm + ((wgid % nig) % gsz); u.pn = (wgid % nig) / gsz; return true;
    }
    __device__ __forceinline__ void a_ready(const Unit&) const {}
    __device__ __forceinline__ void done(const Unit&) const {}
};


__device__ __forceinline__ unsigned cvt_pk_bf16(float lo, float hi) { unsigned r; asm volatile("v_cvt_pk_bf16_f32 %0, %1, %2" : "=v"(r) : "v"(lo), "v"(hi)); return r; }
template <int ACT  > struct EpiBf16 {
    static constexpr bool PERM = true, AFTER_DRAIN = false;
    bf16_t* O; int ldc; unsigned qmask; float qscale;
    __device__ __forceinline__ void operator()(const f32x4 (&acc)[2][2][4][2], const Unit& u, int wr, int wc, int fr, int fq) const {
        const int row0 = u.pm * BM + wr * 64 + fr; const int col0 = u.pn * BM + wc * 32 + 8 * fq;
        const float sc = ((qmask >> u.pn) & 1u) ? qscale : 1.0f;
#pragma unroll
        for (int ai = 0; ai < 2; ++ai)
#pragma unroll
            for (int m = 0; m < 4; ++m) { bf16_t* rowp = O + (size_t)(row0 + ai * HALF + m * 16) * ldc + col0;
#pragma unroll
                for (int bj = 0; bj < 2; ++bj) { f32x4 v0 = acc[ai][bj][m][0], v1 = acc[ai][bj][m][1];
                    if (ACT == 2) {
#pragma unroll
                        for (int e = 0; e < 4; ++e) { const float a = v0[e] > 0.f ? v0[e] : 0.f, b = v1[e] > 0.f ? v1[e] : 0.f; v0[e] = a * a; v1[e] = b * b; } }
                    v0 = v0 * sc; v1 = v1 * sc;
                    u32x4 w; w.x = cvt_pk_bf16(v0[0], v0[1]); w.y = cvt_pk_bf16(v0[2], v0[3]); w.z = cvt_pk_bf16(v1[0], v1[1]); w.w = cvt_pk_bf16(v1[2], v1[3]);
                    *(u32x4*)(rowp + bj * HALF) = w; } }
    }
};
struct EpiResF32 {
    static constexpr bool PERM = false, AFTER_DRAIN = false;
    const float* base; float* out; int ldc; float alpha;
    __device__ __forceinline__ void operator()(const f32x4 (&acc)[2][2][4][2], const Unit& u, int wr, int wc, int fr, int fq) const {
        const int col0 = u.pn * BM + wc * 32 + 4 * fq;
#pragma unroll
        for (int ai = 0; ai < 2; ++ai)
#pragma unroll
            for (int m = 0; m < 4; ++m) { const int r = ai * HALF + wr * 64 + m * 16 + fr; const size_t off = (size_t)(u.pm * BM + r) * ldc + col0;
#pragma unroll
                for (int bj = 0; bj < 2; ++bj)
#pragma unroll
                    for (int n = 0; n < 2; ++n) { const f32x4 bs = *(const f32x4*)(base + off + bj * HALF + n * 16); *(f32x4*)(out + off + bj * HALF + n * 16) = bs * alpha + acc[ai][bj][m][n]; }
                if (m & 1) asm volatile("" ::: "memory"); }
    }
};

template <class Epi, class Sched, bool ALIGN_EPI = false, bool SP2 = false>
__device__ __forceinline__ void gemm_phase(PG8_LAS unsigned char* lds, const Gemm g, const Sched& S, const Epi& E, const int wave_in) {
    int tid_ = fresh_tid_w(wave_in); const int tid = tid_, wid = __builtin_amdgcn_readfirstlane(tid >> 6), lane = tid & 63, wr = wid >> 2, wc = wid & 3, fr = lane & 15, fq = lane >> 4;
    const int K = g.K, nt = K / BK;
    unsigned voffA[2], voffB[2];
#pragma unroll
    for (int i = 0; i < 2; ++i) { int R, C; stage_rc(tid * 16 + i * 8192, R, C); const int Rb = Epi::PERM ? ((R & ~31) + perm32(R & 31)) : R;
        voffA[i] = (unsigned)(R * K + C) * 2u; voffB[i] = (unsigned)(Rb * K + C) * 2u; }
    const size_t kstep = (size_t)(BK * 2);
    const size_t hstep = (size_t)HALF * K * 2;
    const size_t tstep = 2 * hstep;
    const unsigned ldsw = (unsigned)wid * 1024u;
    const int aoff = lds_byte(wr * 64 + fr, fq * 8), boff = lds_byte(wc * 32 + fr, fq * 8);
#define PG8_SA(b, h) (((b) * 2 + (h)) * HTB)
#define PG8_SB(b, h) ((4 + (b) * 2 + (h)) * HTB)
#define PG8_STAGE(bufoff, gbase, voff) do { _Pragma("unroll") for (int _i = 0; _i < 2; ++_i) \
        __builtin_amdgcn_global_load_lds((const unsigned*)((const char*)(gbase) + (voff)[_i]), (PG8_LAS unsigned*)(lds + (bufoff) + ldsw + _i * 8192), 16, 0, 0); } while (0)
#define PG8_LDA(dst, b, h) do { _Pragma("unroll") for (int m = 0; m < 4; ++m) _Pragma("unroll") for (int k = 0; k < 2; ++k) dst[m][k] = *(const PG8_LAS bf16x8*)(lds + PG8_SA(b, h) + aoff + m * 2048 + k * 1024); } while (0)
#define PG8_LDB(dst, b, h) do { _Pragma("unroll") for (int n = 0; n < 2; ++n) _Pragma("unroll") for (int k = 0; k < 2; ++k) dst[n][k] = *(const PG8_LAS bf16x8*)(lds + PG8_SB(b, h) + boff + n * 2048 + k * 1024); } while (0)
#define PG8_MMA(ai, bj, At, Bt) do { __builtin_amdgcn_s_setprio(1); _Pragma("unroll") for (int m = 0; m < 4; ++m) _Pragma("unroll") for (int n = 0; n < 2; ++n) _Pragma("unroll") for (int k = 0; k < 2; ++k) \
        acc[ai][bj][m][n] = __builtin_amdgcn_mfma_f32_16x16x32_bf16(Bt[n][k], At[m][k], acc[ai][bj][m][n], 0, 0, 0); __builtin_amdgcn_s_setprio(0); } while (0)
#define PG8_WAIT_V(n) asm volatile("s_waitcnt vmcnt(" #n ")" ::: "memory")
#define PG8_WAIT_L(n) asm volatile("s_waitcnt lgkmcnt(" #n ")" ::: "memory")
#define PG8_BAR __builtin_amdgcn_s_barrier()
#define PG8_SCHED __builtin_amdgcn_sched_barrier(0)
    Unit cur, nxt; int ui = 0;
    if (!S.next(0, cur)) return;
    f32x4 acc[2][2][4][2];
#pragma unroll
    for (int a = 0; a < 2; ++a)
#pragma unroll
        for (int b = 0; b < 2; ++b)
#pragma unroll
            for (int m = 0; m < 4; ++m)
#pragma unroll
                for (int n = 0; n < 2; ++n) acc[a][b][m][n] = (f32x4){0.f, 0.f, 0.f, 0.f};
    bf16x8 At[4][2], B0[2][2], B1[2][2];
    const char* cA = (const char*)g.A + (size_t)cur.pm * tstep; const char* cB = (const char*)g.Bt + (size_t)cur.pn * tstep;
    S.a_ready(cur);
    if constexpr (SP2) {
        PG8_STAGE(PG8_SB(0, 0), cB, voffB); PG8_STAGE(PG8_SB(0, 1), cB + hstep, voffB); PG8_STAGE(PG8_SA(0, 0), cA, voffA); PG8_STAGE(PG8_SA(0, 1), cA + hstep, voffA);
        if (wr == 1) PG8_BAR;
        PG8_WAIT_V(2); PG8_BAR;
        PG8_STAGE(PG8_SB(1, 0), cB + kstep, voffB); PG8_STAGE(PG8_SA(1, 0), cA + kstep, voffA); PG8_STAGE(PG8_SB(1, 1), cB + hstep + kstep, voffB);
        PG8_WAIT_V(6); PG8_BAR;
    } else {
        PG8_STAGE(PG8_SB(0, 0), cB, voffB); PG8_STAGE(PG8_SA(0, 0), cA, voffA); PG8_STAGE(PG8_SB(0, 1), cB + hstep, voffB); PG8_STAGE(PG8_SA(0, 1), cA + hstep, voffA);
        if (wr == 1) PG8_BAR;
        PG8_WAIT_V(4); PG8_BAR;
        PG8_STAGE(PG8_SB(1, 0), cB + kstep, voffB); PG8_STAGE(PG8_SA(1, 0), cA + kstep, voffA); PG8_STAGE(PG8_SB(1, 1), cB + hstep + kstep, voffB);
        PG8_WAIT_V(6); PG8_BAR;
    }
    for (;;) {
        const bool has_next = S.next(ui + 1, nxt);
        const char* nA = has_next ? (const char*)g.A + (size_t)nxt.pm * tstep : cA; const char* nB = has_next ? (const char*)g.Bt + (size_t)nxt.pn * tstep : cB;
        for (int t = 0; t < nt; t += 2) {
            const bool last = (t == nt - 2);
            const char* a1 = cA + (size_t)(t + 1) * kstep;
            const char* a2 = last ? nA : cA + (size_t)(t + 2) * kstep; const char* b2 = last ? nB : cB + (size_t)(t + 2) * kstep;
            const char* a3 = a2 + kstep; const char* b3 = b2 + kstep;
            if (last && has_next) S.a_ready(nxt);
            if constexpr (SP2) {
            PG8_LDB(B0, 0, 0); PG8_LDB(B1, 0, 1); PG8_SCHED; PG8_LDA(At, 0, 0); PG8_STAGE(PG8_SA(1, 1), a1 + hstep, voffA);
            PG8_WAIT_V(8); PG8_WAIT_L(0); PG8_BAR; PG8_MMA(0, 0, At, B0); PG8_MMA(0, 1, At, B1); PG8_BAR; PG8_SCHED;
            PG8_LDA(At, 0, 1); PG8_STAGE(PG8_SB(0, 0), b2, voffB); PG8_STAGE(PG8_SB(0, 1), b2 + hstep, voffB); PG8_STAGE(PG8_SA(0, 0), a2, voffA);
            PG8_WAIT_V(8); PG8_WAIT_L(0); PG8_BAR; PG8_MMA(1, 0, At, B0); PG8_MMA(1, 1, At, B1); PG8_BAR; PG8_SCHED;
            PG8_LDB(B0, 1, 0); PG8_LDB(B1, 1, 1); PG8_SCHED; PG8_LDA(At, 1, 0); PG8_STAGE(PG8_SA(0, 1), a2 + hstep, voffA);
            PG8_WAIT_V(8); PG8_WAIT_L(0); PG8_BAR; PG8_MMA(0, 0, At, B0); PG8_MMA(0, 1, At, B1); PG8_BAR; PG8_SCHED;
            PG8_LDA(At, 1, 1); PG8_STAGE(PG8_SB(1, 0), b3, voffB); PG8_STAGE(PG8_SB(1, 1), b3 + hstep, voffB); PG8_STAGE(PG8_SA(1, 0), a3, voffA);
            PG8_WAIT_V(8); PG8_WAIT_L(0); PG8_BAR; PG8_MMA(1, 0, At, B0); PG8_MMA(1, 1, At, B1); PG8_BAR; PG8_SCHED;
            } else {
            PG8_LDB(B0, 0, 0); PG8_SCHED; PG8_LDA(At, 0, 0); PG8_STAGE(PG8_SA(1, 1), a1 + hstep, voffA);
            PG8_WAIT_L(8); PG8_BAR; PG8_WAIT_L(0); PG8_MMA(0, 0, At, B0); PG8_BAR; PG8_SCHED;
            PG8_LDB(B1, 0, 1); PG8_STAGE(PG8_SB(0, 0), b2, voffB);
            PG8_BAR; PG8_WAIT_L(0); PG8_MMA(0, 1, At, B1); PG8_BAR;
            PG8_LDA(At, 0, 1); PG8_STAGE(PG8_SA(0, 0), a2, voffA);
            PG8_BAR; PG8_WAIT_L(0); PG8_MMA(1, 0, At, B0); PG8_BAR; PG8_SCHED;
            PG8_STAGE(PG8_SB(0, 1), b2 + hstep, voffB);
            PG8_WAIT_V(6); PG8_BAR; PG8_MMA(1, 1, At, B1); PG8_BAR;
            PG8_LDB(B0, 1, 0); PG8_SCHED; PG8_LDA(At, 1, 0); PG8_STAGE(PG8_SA(0, 1), a2 + hstep, voffA);
            PG8_WAIT_L(8); PG8_BAR; PG8_WAIT_L(0); PG8_MMA(0, 0, At, B0); PG8_BAR; PG8_SCHED;
            PG8_LDB(B1, 1, 1); PG8_STAGE(PG8_SB(1, 0), b3, voffB);
            PG8_BAR; PG8_WAIT_L(0); PG8_MMA(0, 1, At, B1); PG8_BAR;
            PG8_LDA(At, 1, 1); PG8_STAGE(PG8_SA(1, 0), a3, voffA);
            PG8_BAR; PG8_WAIT_L(0); PG8_MMA(1, 0, At, B0); PG8_BAR; PG8_SCHED;
            PG8_STAGE(PG8_SB(1, 1), b3 + hstep, voffB);
            PG8_WAIT_V(6); PG8_BAR; PG8_MMA(1, 1, At, B1); PG8_BAR;
            }
        }
        if constexpr (ALIGN_EPI) { if (wr == 0) PG8_BAR; }
        if constexpr (!Epi::AFTER_DRAIN) { E(acc, cur, wr, wc, fr, fq); S.done(cur); }
        if (!has_next) break;
#pragma unroll
        for (int a = 0; a < 2; ++a)
#pragma unroll
            for (int b = 0; b < 2; ++b)
#pragma unroll
                for (int m = 0; m < 4; ++m)
#pragma unroll
                    for (int n = 0; n < 2; ++n) acc[a][b][m][n] = (f32x4){0.f, 0.f, 0.f, 0.f};
        cur = nxt; cA = nA; cB = nB; ++ui;
        if constexpr (ALIGN_EPI) { if (wr == 1) PG8_BAR; }
    }
    PG8_WAIT_V(0);
    if constexpr (!ALIGN_EPI) { if (wr == 0) PG8_BAR; }
    PG8_BAR;
    if constexpr (Epi::AFTER_DRAIN) { E.fused(acc, cur, wr, wc, fr, fq, lds, wid, lane); S.done(cur); }
#undef PG8_SA
#undef PG8_SB
#undef PG8_STAGE
#undef PG8_LDA
#undef PG8_LDB
#undef PG8_MMA
#undef PG8_WAIT_V
#undef PG8_WAIT_L
#undef PG8_BAR
#undef PG8_SCHED
}
}

#define XB_TMO      128
#define XB_XCNT(j)  (256  + 64 * (j))
#define XB_XSUB(j)  (1280 + 64 * (j))
#define XB_XGEN(j)  (2304 + 64 * (j))
#define XB_TOP      3328
#define XB_TOPGEN   3392
#define XCD_BAR_WORDS 3456
#define XB_SPIN_CAP (1u << 26)

__device__ __forceinline__ unsigned xb_ld(unsigned* p)              { return __hip_atomic_load(p, __ATOMIC_RELAXED, __HIP_MEMORY_SCOPE_AGENT); }
__device__ __forceinline__ unsigned xb_add(unsigned* p, unsigned v) { return __hip_atomic_fetch_add(p, v, __ATOMIC_RELAXED, __HIP_MEMORY_SCOPE_AGENT); }
__device__ __forceinline__ unsigned xb_xcc_id() { return (unsigned)__builtin_amdgcn_s_getreg((3 << 11) | 20) & 0xFu; }
#define XB_SPIN(cond, bar) do { unsigned _sp = 0; while (cond) { __builtin_amdgcn_s_sleep(1); \
    if ((++_sp & 255u) == 0u) { if (xb_ld(&(bar)[XB_TMO])) break; if (_sp > XB_SPIN_CAP) { atomicAdd(&(bar)[XB_TMO], 1u); break; } } } } while (0)

struct XcdBarrier {
    unsigned* bar; unsigned x;
    volatile LAS unsigned* st;
};

__device__ __forceinline__ XcdBarrier xcd_barrier_post(unsigned* bar, volatile LAS unsigned* st) {
    XcdBarrier b; b.bar = bar; b.x = xb_xcc_id(); b.st = st;
    if (threadIdx.x == 0) (void)xb_add(&bar[XB_XCNT(b.x)], 1u);
    return b;
}
__device__ __forceinline__ void xcd_barrier_complete(unsigned* bar, unsigned x, unsigned& nloc, unsigned& nx) {
    const unsigned G = gridDim.x * gridDim.y * gridDim.z;
    unsigned sum, cnt, mine, sp = 0u;
    for (;;) {
        sum = 0u; cnt = 0u; mine = 0u;
#pragma unroll
        for (unsigned j = 0; j < 16; ++j) { const unsigned c = xb_ld(&bar[XB_XCNT(j)]); sum += c; cnt += (c > 0u) ? 1u : 0u; mine = (j == x) ? c : mine; }
        if (sum == G) break;
        __builtin_amdgcn_s_sleep(1);
        if ((++sp & 255u) == 0u) { if (xb_ld(&bar[XB_TMO])) break; if (sp > XB_SPIN_CAP) { atomicAdd(&bar[XB_TMO], 1u); break; } }
    }
    nloc = mine > 0u ? mine : 1u; nx = cnt > 0u ? cnt : 1u;
}

__device__ __forceinline__ void xcd_barrier(const XcdBarrier& b) {
    asm volatile("s_waitcnt vmcnt(0)" ::: "memory");
    __syncthreads();
    if (threadIdx.x == 0) {
        unsigned* bar = b.bar;
        __builtin_amdgcn_s_waitcnt(0);
        unsigned nloc = b.st[0], nx = b.st[1];
        if (nloc == 0u) { xcd_barrier_complete(bar, b.x, nloc, nx); b.st[0] = nloc; b.st[1] = nx; }
        const unsigned old = xb_add(&bar[XB_XSUB(b.x)], 1u);
        const unsigned gen = old / nloc;
        if (old + 1u == (gen + 1u) * nloc) {
            __builtin_amdgcn_fence(__ATOMIC_RELEASE, "agent");
            asm volatile("s_waitcnt vmcnt(0)" ::: "memory");
            const unsigned og = xb_add(&bar[XB_TOP], 1u);
            const unsigned tg = og / nx;
            if (og + 1u == (tg + 1u) * nx) xb_add(&bar[XB_TOPGEN], 1u);
            else XB_SPIN(xb_ld(&bar[XB_TOPGEN]) == tg, bar);
            __builtin_amdgcn_fence(__ATOMIC_ACQUIRE, "agent");
            xb_add(&bar[XB_XGEN(b.x)], 1u);
            asm volatile("s_waitcnt vmcnt(0)" ::: "memory");
        } else {
            XB_SPIN(xb_ld(&bar[XB_XGEN(b.x)]) == gen, bar);
            __builtin_amdgcn_fence(__ATOMIC_ACQUIRE, "agent");
            asm volatile("s_waitcnt vmcnt(0)" ::: "memory");
        }
    }
    __syncthreads();
}


constexpr size_t MiB = 1u << 20;
constexpr size_t WS_CTL = 0, CTL_ZERO_BYTES = 1 * MiB;
constexpr size_t WS_WIN = 1 * MiB;
constexpr size_t WS_WOUT = WS_WIN + 12 * MiB;
constexpr size_t WS_W1 = WS_WOUT + 4 * MiB;
constexpr size_t WS_W2 = WS_W1 + 16 * MiB;
constexpr size_t WS_XB = WS_W2 + 16 * MiB;
constexpr size_t WS_H = WS_XB + 64 * MiB;
constexpr size_t WS_MIX = WS_H + 192 * MiB;
constexpr size_t WS_HFF = WS_H;
constexpr size_t WS_KCV = WS_H + 256 * MiB;
constexpr size_t WS_KM = WS_KCV + 2 * MiB;
constexpr size_t WS_OL = WS_KM + 1 * MiB;
constexpr size_t WS_QP = WS_OL + 32 * MiB;
constexpr size_t WS_U = WS_QP + 32 * MiB;
constexpr size_t WS_DG = WS_U + 4 * MiB;
constexpr size_t WS_LBS = WS_DG + 1 * MiB;
constexpr size_t WS_RES = WS_LBS + 1 * MiB;
constexpr size_t WS_WPT = WS_RES;
constexpr size_t WS_W1CT = WS_RES + 1 * MiB;
constexpr size_t WS_END = WS_RES + 32 * MiB;
static_assert(WS_END <= 512 * MiB, "workspace map");
constexpr int CW_BAR = 4096;
constexpr int RING_BYTES = 131072, LDSCTL_OFF = RING_BYTES, MISC_OFF = LDSCTL_OFF + 320, LDS_BYTES = 147456;
constexpr int HSEG = 512, NSEG = S_ / HSEG, HT = 32;

__device__ __forceinline__ float dot64(const float (&q)[64], const float* __restrict__ k) {
    float s0 = 0.f, s1 = 0.f, s2 = 0.f, s3 = 0.f;
#pragma unroll
    for (int d = 0; d < 64; d += 4) { const float4 kv = *(const float4*)(k + d); s0 = fmaf(q[d], kv.x, s0); s1 = fmaf(q[d + 1], kv.y, s1); s2 = fmaf(q[d + 2], kv.z, s2); s3 = fmaf(q[d + 3], kv.w, s3); }
    return (s0 + s1) + (s2 + s3);
}
__device__ __forceinline__ float dot64(const float (&q)[64], const bf16_t* __restrict__ k) {
    float s0 = 0.f, s1 = 0.f, s2 = 0.f, s3 = 0.f;
#pragma unroll
    for (int c = 0; c < 8; ++c) { const uint4 w = *(const uint4*)(k + 8 * c);
        s0 = fmaf(q[8 * c + 0], __uint_as_float(w.x << 16), s0); s1 = fmaf(q[8 * c + 1], __uint_as_float(w.x & 0xffff0000u), s1);
        s2 = fmaf(q[8 * c + 2], __uint_as_float(w.y << 16), s2); s3 = fmaf(q[8 * c + 3], __uint_as_float(w.y & 0xffff0000u), s3);
        s0 = fmaf(q[8 * c + 4], __uint_as_float(w.z << 16), s0); s1 = fmaf(q[8 * c + 5], __uint_as_float(w.z & 0xffff0000u), s1);
        s2 = fmaf(q[8 * c + 6], __uint_as_float(w.w << 16), s2); s3 = fmaf(q[8 * c + 7], __uint_as_float(w.w & 0xffff0000u), s3); }
    return (s0 + s1) + (s2 + s3);
}
__device__ __forceinline__ void axpy64(float p, const float* __restrict__ v, float (&o)[64]) {
#pragma unroll
    for (int d = 0; d < 64; d += 4) { const float4 vv = *(const float4*)(v + d); o[d] = fmaf(p, vv.x, o[d]); o[d + 1] = fmaf(p, vv.y, o[d + 1]); o[d + 2] = fmaf(p, vv.z, o[d + 2]); o[d + 3] = fmaf(p, vv.w, o[d + 3]); }
}
__device__ __forceinline__ void axpy64(float p, const bf16_t* __restrict__ v, float (&o)[64]) {
#pragma unroll
    for (int c = 0; c < 8; ++c) { const uint4 w = *(const uint4*)(v + 8 * c);
        o[8 * c + 0] = fmaf(p, __uint_as_float(w.x << 16), o[8 * c + 0]); o[8 * c + 1] = fmaf(p, __uint_as_float(w.x & 0xffff0000u), o[8 * c + 1]);
        o[8 * c + 2] = fmaf(p, __uint_as_float(w.y << 16), o[8 * c + 2]); o[8 * c + 3] = fmaf(p, __uint_as_float(w.y & 0xffff0000u), o[8 * c + 3]);
        o[8 * c + 4] = fmaf(p, __uint_as_float(w.z << 16), o[8 * c + 4]); o[8 * c + 5] = fmaf(p, __uint_as_float(w.z & 0xffff0000u), o[8 * c + 5]);
        o[8 * c + 6] = fmaf(p, __uint_as_float(w.w << 16), o[8 * c + 6]); o[8 * c + 7] = fmaf(p, __uint_as_float(w.w & 0xffff0000u), o[8 * c + 7]); }
}
template <typename TV>
__device__ __forceinline__ void osm_step(float s, const TV* __restrict__ v, float& m, float& l, float (&o)[64]) {
    if (s > m) { const float f = expf(m - s); l *= f;
#pragma unroll
        for (int d = 0; d < 64; ++d) o[d] *= f;
        m = s; }
    const float p = expf(s - m); l += p;
    axpy64(p, v, o);
}
__device__ __forceinline__ void load_q64(float (&q)[64], const float* p, float sc) {
#pragma unroll
    for (int d = 0; d < 64; ++d) q[d] = p[d] * sc;
}
__device__ __forceinline__ void load_q64(float (&q)[64], const bf16_t* p, float sc) {
#pragma unroll
    for (int c = 0; c < 8; ++c) { const uint4 w = *(const uint4*)(p + 8 * c);
        q[8 * c + 0] = __uint_as_float(w.x << 16) * sc; q[8 * c + 1] = __uint_as_float(w.x & 0xffff0000u) * sc; q[8 * c + 2] = __uint_as_float(w.y << 16) * sc; q[8 * c + 3] = __uint_as_float(w.y & 0xffff0000u) * sc;
        q[8 * c + 4] = __uint_as_float(w.z << 16) * sc; q[8 * c + 5] = __uint_as_float(w.z & 0xffff0000u) * sc; q[8 * c + 6] = __uint_as_float(w.w << 16) * sc; q[8 * c + 7] = __uint_as_float(w.w & 0xffff0000u) * sc; }
}
__device__ __forceinline__ void store_row64(bf16_t* p, const float (&o)[64], float sc) {
#pragma unroll
    for (int c = 0; c < 8; ++c) { uint4 w; w.x = pk2(o[8 * c] * sc, o[8 * c + 1] * sc); w.y = pk2(o[8 * c + 2] * sc, o[8 * c + 3] * sc); w.z = pk2(o[8 * c + 4] * sc, o[8 * c + 5] * sc); w.w = pk2(o[8 * c + 6] * sc, o[8 * c + 7] * sc); *(uint4*)(p + 8 * c) = w; }
}


#ifndef NSA_INLINE
#define NSA_INLINE __forceinline__
#endif
namespace att {
typedef short bf16x8 __attribute__((ext_vector_type(8)));
typedef short s16x4 __attribute__((ext_vector_type(4)));
typedef short v4i16_t __attribute__((ext_vector_type(4)));
typedef float f32x16 __attribute__((ext_vector_type(16)));
typedef unsigned u32x4 __attribute__((ext_vector_type(4)));
typedef float f32x2_t __attribute__((ext_vector_type(2)));
typedef __bf16 bf16x2_t __attribute__((ext_vector_type(2)));
constexpr float LOG2E = 1.4426950408889634f, C2 = 0.125f * LOG2E, NEG_INF = -INFINITY, THR = 8.0f;
constexpr int L_KV = 0, KVBUF = 16384, NSLOT = 4, L_WSF = 65536, L_TABD = 67584, L_IMP = 71680, L_SEL = 104960, L_OST = 0  , L_END = 105984;
typedef LAS const unsigned char* lcp;

__device__ __forceinline__ int crow(int r, int hi) { return (r & 3) + 8 * (r >> 2) + 4 * hi; }
__device__ __forceinline__ unsigned cvtpk(float lo, float hi) { f32x2_t v = {lo, hi}; bf16x2_t b = __builtin_convertvector(v, bf16x2_t); return __builtin_bit_cast(unsigned, b); }
__device__ __forceinline__ float swapmax(float m) { auto rr = __builtin_amdgcn_permlane32_swap(__float_as_uint(m), __float_as_uint(m), false, false); return fmaxf(__uint_as_float(rr[0]), __uint_as_float(rr[1])); }
__device__ __forceinline__ float swapsum(float m) { auto rr = __builtin_amdgcn_permlane32_swap(__float_as_uint(m), __float_as_uint(m), false, false); return __uint_as_float(rr[0]) + __uint_as_float(rr[1]); }

__device__ __forceinline__ float qx1(float x) { return __uint_as_float((unsigned)__builtin_amdgcn_mov_dpp((int)__float_as_uint(x), 0xB1, 0xF, 0xF, true)); }
__device__ __forceinline__ float qx2(float x) { return __uint_as_float((unsigned)__builtin_amdgcn_mov_dpp((int)__float_as_uint(x), 0x4E, 0xF, 0xF, true)); }
__device__ __forceinline__ int ix1(int x) { return __builtin_amdgcn_mov_dpp(x, 0xB1, 0xF, 0xF, true); }
__device__ __forceinline__ int ix2(int x) { return __builtin_amdgcn_mov_dpp(x, 0x4E, 0xF, 0xF, true); }
__device__ __forceinline__ int ix4(int x) { return __builtin_amdgcn_ds_swizzle(x, 0x101F); }

__device__ __forceinline__ void glds16(const void* gsrc, unsigned lds_dst) { unsigned keep;
    asm volatile("s_mov_b32 %0, m0\n\ts_mov_b32 m0, %2\n\ts_nop 0\n\tglobal_load_lds_dwordx4 %1, off\n\ts_mov_b32 m0, %0" : "=&s"(keep) : "v"(gsrc), "s"(lds_dst) : "memory"); }
template <bool WITHV>
__device__ __forceinline__ void kv_dma(const bf16_t* Kp, const bf16_t* Vp, int row0, int pitch, unsigned slot_addr, int wid) {
    const int lane = fresh_lane();
    glds16(Kp + (size_t)(row0 + lane) * pitch + wid * 8, (unsigned)__builtin_amdgcn_readfirstlane(slot_addr + wid * 1024));
    if (WITHV) glds16(Vp + (size_t)(row0 + 16 * (wid & 3) + (lane >> 2)) * pitch + (wid >> 2) * 32 + (lane & 3) * 8, (unsigned)__builtin_amdgcn_readfirstlane(slot_addr + 8192 + wid * 1024));
}
__device__ __forceinline__ void wait_tiles(int n  ) {
    if (n >= 4) asm volatile("s_waitcnt vmcnt(4) lgkmcnt(0)" ::: "memory");
    else if (n == 2) asm volatile("s_waitcnt vmcnt(2) lgkmcnt(0)" ::: "memory");
    else if (n == 1) asm volatile("s_waitcnt vmcnt(1) lgkmcnt(0)" ::: "memory");
    else asm volatile("s_waitcnt vmcnt(0) lgkmcnt(0)" ::: "memory");
    __builtin_amdgcn_s_barrier();
    asm volatile("" ::: "memory");
}
__device__ __forceinline__ void qk_tile(f32x16& p0, f32x16& p1, lcp Kb, const bf16x8 (&qr)[4], const f32x16& C) {
    const int ln = fresh_lane(); lcp kb = Kb + (ln >> 5) * 1024 + (ln & 31) * 16;
    bf16x8 kf[8];
#pragma unroll
    for (int d0 = 0; d0 < 4; ++d0) { kf[2 * d0] = *(const LAS bf16x8*)(kb + d0 * 2048); kf[2 * d0 + 1] = *(const LAS bf16x8*)(kb + d0 * 2048 + 512); }
    p0 = __builtin_amdgcn_mfma_f32_32x32x16_bf16(kf[0], qr[0], C, 0, 0, 0); p1 = __builtin_amdgcn_mfma_f32_32x32x16_bf16(kf[1], qr[0], C, 0, 0, 0);
#pragma unroll
    for (int d0 = 1; d0 < 4; ++d0) { p0 = __builtin_amdgcn_mfma_f32_32x32x16_bf16(kf[2 * d0], qr[d0], p0, 0, 0, 0); p1 = __builtin_amdgcn_mfma_f32_32x32x16_bf16(kf[2 * d0 + 1], qr[d0], p1, 0, 0, 0); }
}
__device__ __forceinline__ s16x4 vtr(lcp p) { return __builtin_bit_cast(s16x4, __builtin_amdgcn_ds_read_tr16_b64_v4i16((LAS v4i16_t*)p)); }
struct VFrag { bf16x8 f[8]; };
__device__ __forceinline__ void v_read(VFrag& V, lcp Vb) {
    const int ln = fresh_lane(); lcp vp = Vb + ((ln >> 4) & 1) * 32 + (ln & 3) * 8 + (4 * (ln >> 5) + ((ln & 15) >> 2)) * 64;
#pragma unroll
    for (int d0 = 0; d0 < 2; ++d0)
#pragma unroll
        for (int ks = 0; ks < 4; ++ks) {
            const s16x4 lo = vtr(vp + d0 * 4096 + ks * 1024), hh = vtr(vp + d0 * 4096 + ks * 1024 + 512);
            V.f[d0 * 4 + ks] = (bf16x8){lo[0], lo[1], lo[2], lo[3], hh[0], hh[1], hh[2], hh[3]};
        }
}
__device__ __forceinline__ void pv_mma(f32x16 (&o)[2], const VFrag& V, const f32x16& p0, const f32x16& p1) {
    u32x4 pw[4];
#pragma unroll
    for (int i = 0; i < 4; ++i) { pw[0][i] = cvtpk(p0[2 * i], p0[2 * i + 1]); pw[1][i] = cvtpk(p0[8 + 2 * i], p0[9 + 2 * i]); pw[2][i] = cvtpk(p1[2 * i], p1[2 * i + 1]); pw[3][i] = cvtpk(p1[8 + 2 * i], p1[9 + 2 * i]); }
#pragma unroll
    for (int ks = 0; ks < 4; ++ks) {
        o[0] = __builtin_amdgcn_mfma_f32_32x32x16_bf16(__builtin_bit_cast(bf16x8, pw[ks]), V.f[ks], o[0], 0, 0, 0);
        o[1] = __builtin_amdgcn_mfma_f32_32x32x16_bf16(__builtin_bit_cast(bf16x8, pw[ks]), V.f[4 + ks], o[1], 0, 0, 0);
    }
}
template <int STRIDE, int W>
__device__ __forceinline__ void bias_near(f32x16& p0, f32x16& p1, int D0, const LAS float* tabdh, float mref, bool colok, int hi) {
    int Dh = colok ? D0 - STRIDE * 4 * hi : -(1 << 29); asm volatile("" : "+v"(Dh));
    const LAS float* tb = tabdh; float nm = -mref;
#pragma unroll
    for (int r = 0; r < 16; ++r) {
        const int d0 = Dh - STRIDE * ((r & 3) + 8 * (r >> 2)), d1 = d0 - STRIDE * 32;
        const int i0 = min(max(d0, 0), 127), i1 = min(max(d1, 0), 127);
        const float b0 = tb[i0] + nm, b1 = tb[i1] + nm;
        p0[r] = ((unsigned)d0 < (unsigned)W) ? p0[r] + b0 : NEG_INF;
        p1[r] = ((unsigned)d1 < (unsigned)W) ? p1[r] + b1 : NEG_INF;
    }
}
__device__ __forceinline__ float fadd_s(float a, float b) { float r; asm("v_add_f32_e32 %0, %1, %2" : "=v"(r) : "v"(a), "v"(b)); return r; }
#define MX3_(a, b, c) __builtin_fmaxf(__builtin_fmaxf((a), (b)), (c))
__device__ __forceinline__ float rowmax32(const f32x16& p0, const f32x16& p1) {
    float a = MX3_(p0[0], p0[1], p1[0]), b = MX3_(p0[2], p0[3], p1[1]); a = MX3_(a, p1[2], p1[3]);
#pragma unroll
    for (int r = 4; r < 16; r += 4) { a = MX3_(a, p0[r], p0[r + 1]); b = MX3_(b, p0[r + 2], p0[r + 3]); a = MX3_(a, p1[r], p1[r + 1]); b = MX3_(b, p1[r + 2], p1[r + 3]); }
    return swapmax(__builtin_fmaxf(a, b));
}
__device__ __forceinline__ float rowmax_part(const f32x16& p0, const f32x16& p1) {
    float a = MX3_(p0[0], p0[1], p1[0]), b = MX3_(p0[2], p0[3], p1[1]); a = MX3_(a, p1[2], p1[3]);
#pragma unroll
    for (int r = 4; r < 16; r += 4) { a = MX3_(a, p0[r], p0[r + 1]); b = MX3_(b, p0[r + 2], p0[r + 3]); a = MX3_(a, p1[r], p1[r + 1]); b = MX3_(b, p1[r + 2], p1[r + 3]); }
    return __builtin_fmaxf(a, b);
}
__device__ __forceinline__ void scale_rows(f32x16 (&o)[2], float f, LAS float* wsf, int r32, int hi) {
    if (hi == 0) wsf[r32] = f;
    asm volatile("s_waitcnt lgkmcnt(0)" ::: "memory");
#pragma unroll
    for (int g = 0; g < 4; ++g) { const f32x4_t fv = *(const LAS f32x4_t*)(wsf + 8 * g + 4 * hi);
#pragma unroll
        for (int i = 0; i < 4; ++i) { o[0][4 * g + i] *= fv[i]; o[1][4 * g + i] *= fv[i]; } }
    asm volatile("" : "+v"(o[0]), "+v"(o[1]));
    asm volatile("s_waitcnt lgkmcnt(0)" ::: "memory");
}
__device__ __forceinline__ void axpy_rows(unsigned (&accp)[2][8], const f32x16 (&o)[2], float f, LAS float* wsf, int r32, int hi) {
    if (hi == 0) wsf[r32] = f;
    asm volatile("s_waitcnt lgkmcnt(0)" ::: "memory");
#pragma unroll
    for (int g = 0; g < 4; ++g) { const f32x4_t fv = *(const LAS f32x4_t*)(wsf + 8 * g + 4 * hi);
#pragma unroll
        for (int d = 0; d < 2; ++d)
#pragma unroll
            for (int i = 0; i < 2; ++i) { const unsigned w = accp[d][2 * g + i];
                accp[d][2 * g + i] = cvtpk(fmaf(fv[2 * i], o[d][4 * g + 2 * i], QLO(w)), fmaf(fv[2 * i + 1], o[d][4 * g + 2 * i + 1], QHI(w))); asm volatile("" : "+v"(accp[d][2 * g + i])); } }
    asm volatile("s_waitcnt lgkmcnt(0)" ::: "memory");
}
__device__ __forceinline__ void axpy_rows_lds(LAS unsigned* accl, const f32x16 (&o)[2], float f, LAS float* wsf, int lane, int r32, int hi) {
    if (hi == 0) wsf[r32] = f;
    asm volatile("s_waitcnt lgkmcnt(0)" ::: "memory");
#pragma unroll
    for (int g = 0; g < 4; ++g) { const f32x4_t fv = *(const LAS f32x4_t*)(wsf + 8 * g + 4 * hi);
#pragma unroll
        for (int d = 0; d < 2; ++d)
#pragma unroll
            for (int i = 0; i < 2; ++i) { const int e = d * 8 + 2 * g + i; const unsigned w = accl[e * 64 + lane];
                accl[e * 64 + lane] = cvtpk(fmaf(fv[2 * i], o[d][4 * g + 2 * i], QLO(w)), fmaf(fv[2 * i + 1], o[d][4 * g + 2 * i + 1], QHI(w))); } }
    asm volatile("s_waitcnt lgkmcnt(0)" ::: "memory");
}
__device__ __forceinline__ void osm_update(f32x16& p0, f32x16& p1, float& mref, bool& fresh, float& l, float& negm, f32x16 (&o)[2], f32x16& q0, f32x16& q1, bool other_far, bool with_o,
                                           LAS float* wsf, int r32, int hi) {
    const float rm = rowmax32(p0, p1);
    const bool valid = rm > NEG_INF, upd = valid && (fresh || rm > THR);
    if (__any(upd)) {
        const float delta = upd ? rm : 0.f, f = fresh ? 1.0f : __builtin_amdgcn_exp2f(-delta);
        mref += delta; l *= f;
        negm -= delta;
#pragma unroll
        for (int r = 0; r < 16; ++r) { p0[r] -= delta; p1[r] -= delta; }
        if (other_far) {
#pragma unroll
            for (int r = 0; r < 16; ++r) { q0[r] -= delta; q1[r] -= delta; } }
        if (with_o) scale_rows(o, f, wsf, r32, hi);
        fresh = fresh && !valid;
    }
    float s = 0.f;
#pragma unroll
    for (int r = 0; r < 16; ++r) { p0[r] = __builtin_amdgcn_exp2f(p0[r]); p1[r] = __builtin_amdgcn_exp2f(p1[r]); s += p0[r]; s += p1[r]; }
    l += s;
}
__device__ __forceinline__ f32x16 far_c(float negm, bool bit) {
    const float v = bit ? negm : NEG_INF; f32x16 c;
#pragma unroll
    for (int r = 0; r < 16; ++r) c[r] = v;
    return c;
}
template <class RowOff>
__device__ __forceinline__ void store_cols(const f32x16 (&acc)[2], LAS unsigned char* stg, bf16_t* dst, const RowOff& ro, int lane, int r32, int hi) {
    LAS bf16_t* s = (LAS bf16_t*)stg;
#pragma unroll
    for (int r = 0; r < 16; ++r) { const int q = crow(r, hi); s[q * 64 + r32] = (bf16_t)f2bf(acc[0][r]); s[q * 64 + 32 + r32] = (bf16_t)f2bf(acc[1][r]); }
    asm volatile("s_waitcnt lgkmcnt(0)" ::: "memory");
#pragma unroll
    for (int i = 0; i < 4; ++i) { const int q = i * 8 + (lane >> 3), ch = lane & 7; const u32x4 v = *(const LAS u32x4*)(stg + q * 128 + ch * 16); *(u32x4*)(dst + ro(q) + ch * 8) = v; }
    asm volatile("s_waitcnt lgkmcnt(0)" ::: "memory");
}
struct RowOffNsa { size_t base; __device__ __forceinline__ size_t operator()(int q) const { return base + (size_t)(q >> 2) * DM + (q & 3) * 64; } };
struct RowOffTok { size_t base; __device__ __forceinline__ size_t operator()(int q) const { return base + (size_t)q * DM; } };

__device__ __forceinline__ void build_tabd(LAS unsigned char* lds, const float* __restrict__ rel, int tid) {
    LAS float* tabd = (LAS float*)(lds + L_TABD);
    for (int i = tid; i < 8 * 128; i += NTHR) tabd[i] = rel[(i >> 7) * 32 + rel_bucket(i & 127)] * LOG2E;
    __syncthreads();
}

#define ATT_STEP_(t, C0, C1, fC, nC, N0, N1, fN, nN) do { const int t_ = (t); \
        if (t_ + 3 < nt_) kv_dma<WV_>(KP_, VP_, ROW_(t_ + 3), PI_, ring_ + ((t_ + 3) & 3) * KVBUF, wid); \
        fN = false; nN = false; \
        if (t_ + 1 < nt_) { PRE_(t_ + 1, (lds + L_KV + ((t_ + 1) & 3) * KVBUF), N0, N1, fN, nN); } \
        { POST_(t_, (lds + L_KV + (t_ & 3) * KVBUF), C0, C1, fC, nC, N0, N1, (fN && nN)); } \
        { const int last_ = (t_ + 3 < nt_) ? t_ + 3 : nt_ - 1; const int fly_ = last_ - (t_ + 2); wait_tiles(fly_ > 0 ? NI_ * fly_ : 0); } } while (0)
#define ATT_PIPE_BEGIN(nt, Kp, Vp, PITCH, WITHV) { \
    const int nt_ = (nt); constexpr bool WV_ = (WITHV); constexpr int NI_ = WV_ ? 2 : 1; const unsigned ring_ = (unsigned)(uintptr_t)(lds + L_KV); \
    const bf16_t* KP_ = (Kp); const bf16_t* VP_ = (Vp); const int PI_ = (PITCH); \
    if (nt_ > 0) { f32x16 pA0, pA1, pB0, pB1; bool fA = false, fB = false, nA = false, nB = false; \
      kv_dma<WV_>(KP_, VP_, ROW_(0), PI_, ring_, wid); \
      if (nt_ > 1) kv_dma<WV_>(KP_, VP_, ROW_(1), PI_, ring_ + KVBUF, wid); \
      if (nt_ > 2) kv_dma<WV_>(KP_, VP_, ROW_(2), PI_, ring_ + 2 * KVBUF, wid); \
      wait_tiles(NI_ * ((nt_ > 3 ? 3 : nt_) - 1)); \
      { PRE_(0, (lds + L_KV), pA0, pA1, fA, nA); } \
      if (nt_ > 1) wait_tiles(NI_ * ((nt_ > 3 ? 3 : nt_) - 2)); \
      for (int it = 0; it < nt_; it += 2) { \
        ATT_STEP_(it, pA0, pA1, fA, nA, pB0, pB1, fB, nB); \
        if (it + 1 < nt_) ATT_STEP_(it + 1, pB0, pB1, fB, nB, pA0, pA1, fA, nA); } } }

#define SBAR_() __builtin_amdgcn_sched_barrier(0)
#ifdef REP_X_BAR
#define XPROBE_BAR_() do { __builtin_amdgcn_s_barrier(); asm volatile("" ::: "memory"); } while (0)
#else
#define XPROBE_BAR_() do {} while (0)
#endif
__device__ __forceinline__ float att_fused(f32x16& c0, f32x16& c1, f32x16& n0, f32x16& n1, float cval, lcp Kn, lcp Vc, const bf16x8 (&qr)[4], float& l, f32x16 (&o)[2]) {
    const int ln = fresh_lane(); lcp kb = Kn + (ln >> 5) * 1024 + (ln & 31) * 16;
    bf16x8 kf[8];
#pragma unroll
    for (int d0 = 0; d0 < 4; ++d0) { kf[2 * d0] = *(const LAS bf16x8*)(kb + d0 * 2048); kf[2 * d0 + 1] = *(const LAS bf16x8*)(kb + d0 * 2048 + 512); }
    VFrag V;
#pragma unroll
    for (int r = 0; r < 16; ++r) { n0[r] = cval; n1[r] = cval; }
    SBAR_();
    asm volatile("" : "+v"(c0), "+v"(c1));
    float s0 = 0.f, s1 = 0.f;
    unsigned pa[8], pb[8];
#pragma unroll
    for (int d0 = 0; d0 < 4; ++d0) {
        n0 = __builtin_amdgcn_mfma_f32_32x32x16_bf16(kf[2 * d0], qr[d0], n0, 0, 0, 0);
#pragma unroll
        for (int r = 4 * d0; r < 4 * d0 + 4; ++r) { c0[r] = __builtin_amdgcn_exp2f(c0[r]); s0 += c0[r]; }
        pa[2 * d0] = cvtpk(c0[4 * d0], c0[4 * d0 + 1]); pa[2 * d0 + 1] = cvtpk(c0[4 * d0 + 2], c0[4 * d0 + 3]);
        SBAR_();
        n1 = __builtin_amdgcn_mfma_f32_32x32x16_bf16(kf[2 * d0 + 1], qr[d0], n1, 0, 0, 0);
#pragma unroll
        for (int r = 4 * d0; r < 4 * d0 + 4; ++r) { c1[r] = __builtin_amdgcn_exp2f(c1[r]); s1 += c1[r]; }
        pb[2 * d0] = cvtpk(c1[4 * d0], c1[4 * d0 + 1]); pb[2 * d0 + 1] = cvtpk(c1[4 * d0 + 2], c1[4 * d0 + 3]);
        if (d0 == 1) v_read(V, Vc);
        SBAR_();
    }
    l += s0 + s1;
    float ma = NEG_INF, mb = NEG_INF;
#pragma unroll
    for (int ks = 0; ks < 4; ++ks) {
        const u32x4 pw = (ks < 2) ? (u32x4){pa[4 * ks], pa[4 * ks + 1], pa[4 * ks + 2], pa[4 * ks + 3]} : (u32x4){pb[4 * (ks - 2)], pb[4 * (ks - 2) + 1], pb[4 * (ks - 2) + 2], pb[4 * (ks - 2) + 3]};
        o[0] = __builtin_amdgcn_mfma_f32_32x32x16_bf16(__builtin_bit_cast(bf16x8, pw), V.f[ks], o[0], 0, 0, 0);
#pragma unroll
        for (int r = 4 * ks; r < 4 * ks + 4; r += 2) ma = MX3_(ma, n0[r], n0[r + 1]);
        SBAR_();
        o[1] = __builtin_amdgcn_mfma_f32_32x32x16_bf16(__builtin_bit_cast(bf16x8, pw), V.f[4 + ks], o[1], 0, 0, 0);
#pragma unroll
        for (int r = 4 * ks; r < 4 * ks + 4; r += 2) mb = MX3_(mb, n1[r], n1[r + 1]);
        SBAR_();
    }
    return __builtin_fmaxf(ma, mb);
}
__device__ __forceinline__ void att_last(f32x16& c0, f32x16& c1, lcp Vc, float& l, f32x16 (&o)[2]) {
    VFrag V; v_read(V, Vc);
    float s = 0.f;
#pragma unroll
    for (int r = 0; r < 16; ++r) { c0[r] = __builtin_amdgcn_exp2f(c0[r]); c1[r] = __builtin_amdgcn_exp2f(c1[r]); s += c0[r] + c1[r]; }
    l += s;
    pv_mma(o, V, c0, c1);
}
__device__ __forceinline__ void ref_check(f32x16& p0, f32x16& p1, float rmp  , float& mref, bool& fresh, float& l, float& negm, f32x16 (&o)[2], LAS float* wsf, int r32_unused, int hi_unused) {
    const float rm = swapmax(rmp);
    const bool valid = rm > NEG_INF, upd = valid && (fresh || rm > THR);
    if (__any(upd)) {
        const float delta = upd ? rm : 0.f, f = fresh ? 1.0f : __builtin_amdgcn_exp2f(-delta);
        mref += delta; l *= f; negm -= delta;
#pragma unroll
        for (int r = 0; r < 16; ++r) { p0[r] -= delta; p1[r] -= delta; }
        { const int l_ = fresh_lane(); scale_rows(o, f, wsf, l_ & 31, l_ >> 5); }
        fresh = fresh && !valid;
    }
}
#define ATT_FSTEP_(t, C0, C1, N0, N1) do { const int t_ = (t); \
        if (t_ + 3 < nt_) kv_dma<true>(KP_, VP_, ROW_(t_ + 3), PI_, ring_ + ((t_ + 3) & 3) * KVBUF, wid); \
        if (t_ + 1 < nt_) { bool far_, bit_; TINFO_(t_ + 1, far_, bit_); \
            float rmp_ = att_fused(C0, C1, N0, N1, far_ ? (bit_ ? negm : NEG_INF) : 0.f, lds + L_KV + ((t_ + 1) & 3) * KVBUF, lds + L_KV + (t_ & 3) * KVBUF + 8192, qr, l, o); \
            if (!far_) { NEARFIX_(t_ + 1, N0, N1, bit_); rmp_ = rowmax_part(N0, N1); } \
            ref_check(N0, N1, rmp_, mref, fresh, l, negm, o, wsf, r32, hi); } \
        else att_last(C0, C1, lds + L_KV + (t_ & 3) * KVBUF + 8192, l, o); \
        { const int last_ = (t_ + 3 < nt_) ? t_ + 3 : nt_ - 1; const int fly_ = last_ - (t_ + 2); wait_tiles(fly_ > 0 ? 2 * fly_ : 0); XPROBE_BAR_(); } } while (0)
#define ATT_FUSE_LOOP(nt, Kp, Vp, PITCH) { \
    const int nt_ = (nt); const unsigned ring_ = (unsigned)(uintptr_t)(lds + L_KV); const bf16_t* KP_ = (Kp); const bf16_t* VP_ = (Vp); const int PI_ = (PITCH); \
    if (nt_ > 0) { f32x16 pA0, pA1, pB0, pB1; \
      kv_dma<true>(KP_, VP_, ROW_(0), PI_, ring_, wid); \
      if (nt_ > 1) kv_dma<true>(KP_, VP_, ROW_(1), PI_, ring_ + KVBUF, wid); \
      if (nt_ > 2) kv_dma<true>(KP_, VP_, ROW_(2), PI_, ring_ + 2 * KVBUF, wid); \
      wait_tiles(2 * ((nt_ > 3 ? 3 : nt_) - 1)); \
      { bool far_, bit_; TINFO_(0, far_, bit_); const f32x16 c_ = far_c(far_ ? negm : 0.f, far_ ? bit_ : true); qk_tile(pA0, pA1, lds + L_KV, qr, c_); \
        if (!far_) { NEARFIX_(0, pA0, pA1, bit_); } \
        ref_check(pA0, pA1, rowmax_part(pA0, pA1), mref, fresh, l, negm, o, wsf, r32, hi); } \
      if (nt_ > 1) wait_tiles(2 * ((nt_ > 3 ? 3 : nt_) - 2)); \
      for (int it = 0; it < nt_; it += 2) { \
        ATT_FSTEP_(it, pA0, pA1, pB0, pB1); \
        if (it + 1 < nt_) ATT_FSTEP_(it + 1, pB0, pB1, pA0, pA1); } } }

__device__ NSA_INLINE void nsa_block(LAS unsigned char* lds, const bf16_t* Hb, const bf16_t* KCb, const bf16_t* VCb, bf16_t* MIXb, int blk, int wid) {
    const int tid = fresh_tid_w(wid), lane = tid & 63, r32 = lane & 31, hi = lane >> 5;
    const int tl = r32 >> 2, h = r32 & 3, tokw = blk * 64 + wid * 8, t = tokw + tl;
    LAS float* wsf = (LAS float*)(lds + L_WSF) + wid * 64;
    const LAS float* tabdh = (const LAS float*)(lds + L_TABD) + h * 128;
    LAS float* imp = (LAS float*)(lds + L_IMP);
    LAS unsigned* selb = (LAS unsigned*)(lds + L_SEL);
    const float tabc = tabdh[127];
    const bf16_t* hrow = Hb + (size_t)t * HP;
    bf16x8 qr[4];
#pragma unroll
    for (int d0 = 0; d0 < 4; ++d0) qr[d0] = *(const bf16x8*)(hrow + LayB::QN + h * 64 + d0 * 16 + hi * 8);
    for (int i = tid; i < 64 * 129; i += NTHR) imp[i] = 0.f;
    if (tid < 256) selb[tid] = 0u;
    const f32x16 z16 = {0.f, 0.f, 0.f, 0.f, 0.f, 0.f, 0.f, 0.f, 0.f, 0.f, 0.f, 0.f, 0.f, 0.f, 0.f, 0.f};
    unsigned accp[2][8]; f32x16 o[2]; float negm;
#pragma unroll
    for (int i = 0; i < 8; ++i) { accp[0][i] = 0u; accp[1][i] = 0u; }
    float mref, l; bool fresh;
#define RESET_SM_() do { mref = 0.f; l = 0.f; fresh = true; o[0] = z16; o[1] = z16; negm = tabc; } while (0)
    __syncthreads();

    const int tmax = blk * 64 + 63, cntmax = tmax >= 31 ? (tmax - 31) / 16 + 1 : 0, ntc = (cntmax + 63) >> 6;
    const int Dc = t - 31;
    const int twmin = tokw;
#define ROW_(i) ((i) * 64)
    RESET_SM_();
#define PRE_(tt, kv, P0, P1, FAR, NEED) do { FAR = (twmin - 31 - 16 * ((tt) * 64 + 63) >= 128); NEED = true; if (FAR) { const f32x16 c_ = far_c(negm, true); qk_tile(P0, P1, kv, qr, c_); } else qk_tile(P0, P1, kv, qr, z16); } while (0)
#define POST_(tt, kv, P0, P1, FAR, NEED, Q0, Q1, QFAR) do { if (!(FAR)) bias_near<16, (1 << 30)>(P0, P1, Dc - 16 * (tt) * 64, tabdh, mref, true, hi); \
        osm_update(P0, P1, mref, fresh, l, negm, o, Q0, Q1, QFAR, false, wsf, r32, hi); } while (0)
    ATT_PIPE_BEGIN(ntc, KCb, VCb, 64, false)
#undef POST_
    {
        const float lt = swapsum(l), inv = lt > 0.f ? 1.0f / lt : 0.f;
#define POST_(tt, kv, P0, P1, FAR, NEED, Q0, Q1, QFAR) do { VFrag vf_; v_read(vf_, kv + 8192); const int n0 = (tt) * 64; if (!(FAR)) bias_near<16, (1 << 30)>(P0, P1, Dc - 16 * n0, tabdh, mref, true, hi); \
        _Pragma("unroll") for (int r = 0; r < 16; ++r) { P0[r] = __builtin_amdgcn_exp2f(P0[r]) * inv; P1[r] = __builtin_amdgcn_exp2f(P1[r]) * inv; } \
        _Pragma("unroll") for (int g = 0; g < 4; ++g) { \
            float a0 = (P0[4 * g] + P0[4 * g + 1]) + (P0[4 * g + 2] + 0.5f * P0[4 * g + 3]), b0 = 0.5f * P0[4 * g + 3]; \
            float a1 = (P1[4 * g] + P1[4 * g + 1]) + (P1[4 * g + 2] + 0.5f * P1[4 * g + 3]), b1 = 0.5f * P1[4 * g + 3]; \
            a0 += qx1(a0); b0 += qx1(b0); a1 += qx1(a1); b1 += qx1(b1); \
            a0 += qx2(a0); b0 += qx2(b0); a1 += qx2(a1); b1 += qx2(b1); \
            if (h == 0) { const int j0 = (n0 >> 2) + 2 * g + hi; float* ip = (float*)(imp + (wid * 8 + tl) * 129 + j0); \
                atomicAdd(ip, a0); atomicAdd(ip + 1, b0); atomicAdd(ip + 8, a1); atomicAdd(ip + 9, b1); } } \
        pv_mma(o, vf_, P0, P1); } while (0)
        ATT_PIPE_BEGIN(ntc, KCb, VCb, 64, true)
#undef POST_
#undef PRE_
        { const float g0 = sigmoidf_(bf2f(hrow[LayB::GN + h * 3 + 0])); axpy_rows(accp, o, g0, wsf, r32, hi); }
    }
#undef ROW_
    __syncthreads();
    {
        const int tok = tid >> 3, part = tid & 7;
        const LAS float* ir = imp + tok * 129;
        const int nf = blk >= 2 ? 3 : blk + 1, nc = blk >= 2 ? blk - 2 : 0, K = 16 - nf;
        unsigned uv[16]; unsigned vm = 0u, fb = 0u;
#pragma unroll
        for (int jj = 0; jj < 16; ++jj) { const int j = part * 16 + jj; const bool cand = (j >= 1) && (j <= blk - 2);
            uv[jj] = cand ? __float_as_uint(ir[j]) : 0u; vm |= cand ? (1u << jj) : 0u;
            fb |= ((j <= blk) && ((j == 0) || (j == blk) || (j == blk - 1))) ? (1u << jj) : 0u; }
        unsigned bits;
        if (nc <= K) bits = vm;
        else {
            unsigned T = 0u;
            for (int bit = 30; bit >= 0; --bit) {
                const unsigned cand = T | (1u << bit); int c = 0;
#pragma unroll
                for (int jj = 0; jj < 16; ++jj) c += (uv[jj] >= cand) ? 1 : 0;
                c += ix1(c); c += ix2(c); c += ix4(c);
                if (c >= K) T = cand;
            }
            unsigned gtb = 0u, eqb = 0u;
#pragma unroll
            for (int jj = 0; jj < 16; ++jj) { gtb |= (uv[jj] > T) ? (1u << jj) : 0u; eqb |= (((vm >> jj) & 1u) && uv[jj] == T) ? (1u << jj) : 0u; }
            int gt = __builtin_popcount(gtb); gt += ix1(gt); gt += ix2(gt); gt += ix4(gt);
            const int need = K - gt;
            const int mine = __builtin_popcount(eqb); int incl = mine;
            { int t_; t_ = __builtin_amdgcn_mov_dpp(incl, 0x111, 0xF, 0xF, true); if (part >= 1) incl += t_; t_ = __builtin_amdgcn_mov_dpp(incl, 0x112, 0xF, 0xF, true); if (part >= 2) incl += t_; t_ = __builtin_amdgcn_mov_dpp(incl, 0x114, 0xF, 0xF, true); if (part >= 4) incl += t_; }
            int before = incl - mine;
            bits = gtb;
#pragma unroll
            for (int jj = 0; jj < 16; ++jj) { if ((eqb >> jj) & 1u) { if (before < need) bits |= 1u << jj; ++before; } }
        }
        bits |= fb;
        atomicOr((unsigned*)(selb + tok * 4 + (part >> 1)), bits << ((part & 1) * 16));
    }
    __syncthreads();
    unsigned sm[4];
#pragma unroll
    for (int i = 0; i < 4; ++i) sm[i] = selb[(wid * 8 + tl) * 4 + i];
    LAS unsigned* accl = (LAS unsigned*)(lds + L_IMP) + wid * 1024;
#pragma unroll
    for (int i = 0; i < 8; ++i) { accl[i * 64 + lane] = accp[0][i]; accl[(8 + i) * 64 + lane] = accp[1][i]; }
    asm volatile("s_waitcnt lgkmcnt(0)" ::: "memory");
    const int Ds = t;
    RESET_SM_();
#define ROW_(i) ((i) * 64)
#define SELBIT_(j) ((((j) < 32 ? sm[0] : ((j) < 64 ? sm[1] : ((j) < 96 ? sm[2] : sm[3]))) >> ((j) & 31)) & 1u)
#define PRE_(tt, kv, P0, P1, FAR, NEED) do { const bool bit_ = SELBIT_(tt); NEED = __any(bit_); FAR = (twmin - ((tt) * 64 + 63) >= 128); \
        if (NEED) { if (FAR) { const f32x16 c_ = far_c(negm, bit_); qk_tile(P0, P1, kv, qr, c_); } else qk_tile(P0, P1, kv, qr, z16); } } while (0)
#define POST_(tt, kv, P0, P1, FAR, NEED, Q0, Q1, QFAR) do { if (NEED) { VFrag vf_; v_read(vf_, kv + 8192); if (!(FAR)) { const bool bit_ = SELBIT_(tt); bias_near<1, (1 << 30)>(P0, P1, Ds - (tt) * 64, tabdh, mref, bit_, hi); } \
        osm_update(P0, P1, mref, fresh, l, negm, o, Q0, Q1, QFAR, true, wsf, r32, hi); pv_mma(o, vf_, P0, P1); } } while (0)
    ATT_PIPE_BEGIN(blk + 1, Hb + LayB::KS, Hb + LayB::VS, HP, true)
#undef POST_
#undef PRE_
#undef ROW_
    { const float lt = swapsum(l), inv = lt > 0.f ? 1.0f / lt : 0.f; const float g1 = sigmoidf_(bf2f(Hb[(size_t)t * HP + LayB::GN + h * 3 + 1])); axpy_rows_lds(accl, o, g1 * inv, wsf, lane, r32, hi); }
    const int jw0 = blk >= 8 ? blk - 8 : 0;
    RESET_SM_();
#define ROW_(i) ((jw0 + (i)) * 64)
#define PRE_(tt, kv, P0, P1, FAR, NEED) do { const int j_ = jw0 + (tt); NEED = true; FAR = (twmin - (j_ * 64 + 63) >= 128) && ((tokw + 7) - j_ * 64 < 512); \
        if (FAR) { const f32x16 c_ = far_c(negm, true); qk_tile(P0, P1, kv, qr, c_); } else qk_tile(P0, P1, kv, qr, z16); } while (0)
#define POST_(tt, kv, P0, P1, FAR, NEED, Q0, Q1, QFAR) do { VFrag vf_; v_read(vf_, kv + 8192); if (!(FAR)) bias_near<1, 512>(P0, P1, Ds - (jw0 + (tt)) * 64, tabdh, mref, true, hi); \
        osm_update(P0, P1, mref, fresh, l, negm, o, Q0, Q1, QFAR, true, wsf, r32, hi); pv_mma(o, vf_, P0, P1); } while (0)
    ATT_PIPE_BEGIN(blk - jw0 + 1, Hb + LayB::KW, Hb + LayB::VW, HP, true)
#undef POST_
#undef PRE_
#undef ROW_
    { const float lt = swapsum(l), inv = lt > 0.f ? 1.0f / lt : 0.f; const float g2 = sigmoidf_(bf2f(Hb[(size_t)t * HP + LayB::GN + h * 3 + 2])); axpy_rows_lds(accl, o, g2 * inv, wsf, lane, r32, hi); }
    {
#pragma unroll
        for (int d = 0; d < 2; ++d)
#pragma unroll
            for (int i = 0; i < 8; ++i) { const unsigned w = accl[(d * 8 + i) * 64 + lane]; o[d][2 * i] = QLO(w); o[d][2 * i + 1] = QHI(w); }
        const int lane2 = fresh_lane(); const RowOffNsa ro{(size_t)tokw * DM}; store_cols(o, lds + L_OST + wid * 4096, MIXb, ro, lane2, lane2 & 31, lane2 >> 5); }
    __syncthreads();
#undef SELBIT_
#undef RESET_SM_
}


#ifdef REP_X_EXP
#define XPROBE_EXP_(P0, P1) do { float d_ = 0.f; _Pragma("unroll") for (int r = 0; r < 16; ++r) { d_ += __builtin_amdgcn_exp2f(P0[r] - 1.0f) + __builtin_amdgcn_exp2f(P1[r] - 1.0f); } asm volatile("" :: "v"(d_)); } while (0)
#else
#define XPROBE_EXP_(P0, P1) do {} while (0)
#endif
#ifdef REP_X_PV
#define XPROBE_PV_(V, P0, P1) do { f32x16 d_[2] = {z16, z16}; pv_mma(d_, V, P0, P1); asm volatile("" :: "v"(d_[0]), "v"(d_[1])); } while (0)
#else
#define XPROBE_PV_(V, P0, P1) do {} while (0)
#endif
__device__ __forceinline__ void moba_block(LAS unsigned char* lds, const bf16_t* Hb, const float* __restrict__ KMh, bf16_t* MIXb, int hd, int own, int wid) {
    const int tid = fresh_tid_w(wid), lane = tid & 63, r32 = lane & 31, hi = lane >> 5;
    LAS float* wsf = (LAS float*)(lds + L_WSF) + wid * 64;
    const LAS float* tabdh = (const LAS float*)(lds + L_TABD) + (4 + hd) * 128;
    LAS float* kml = (LAS float*)(lds + L_IMP);
    LAS unsigned* selb = (LAS unsigned*)(lds + L_SEL);
    const float tabc = tabdh[127];
    for (int i = tid; i < 32 * 64; i += NTHR) kml[i] = KMh[i];
    __syncthreads();
    if (tid < 256) {
        const int tg = own * 256 + tid;
        unsigned q[32];
        load_qp(q, Hb + (size_t)tg * HP + LayB::QM + hd * 64);
        float v0 = -BIGF, v1 = -BIGF, v2 = -BIGF; int i0 = -1, i1 = -1, i2 = -1;
        for (int j = 0; j < own; ++j) {
            const LAS float* kr = kml + j * 64; float s0 = 0.f, s1 = 0.f;
#pragma unroll
            for (int c = 0; c < 16; ++c) { const f32x4_t w = *(const LAS f32x4_t*)(kr + 4 * c);
                s0 = fmaf(QLO(q[2 * c]), w[0], s0); s1 = fmaf(QHI(q[2 * c]), w[1], s1); s0 = fmaf(QLO(q[2 * c + 1]), w[2], s0); s1 = fmaf(QHI(q[2 * c + 1]), w[3], s1); }
            const float g = s0 + s1;
            if (g > v0) { v2 = v1; i2 = i1; v1 = v0; i1 = i0; v0 = g; i0 = j; }
            else if (g > v1) { v2 = v1; i2 = i1; v1 = g; i1 = j; }
            else if (g > v2) { v2 = g; i2 = j; }
        }
        unsigned mk = 0u;
        if (i0 >= 0) mk |= 1u << i0;
        if (i1 >= 0) mk |= 1u << i1;
        if (i2 >= 0) mk |= 1u << i2;
        selb[tid] = mk;
    }
    __syncthreads();
    const int tokw = own * 256 + wid * 32, t = tokw + r32;
    bf16x8 qr[4];
#pragma unroll
    for (int d0 = 0; d0 < 4; ++d0) qr[d0] = *(const bf16x8*)(Hb + (size_t)t * HP + LayB::QM + hd * 64 + d0 * 16 + hi * 8);
    const f32x16 z16 = {0.f, 0.f, 0.f, 0.f, 0.f, 0.f, 0.f, 0.f, 0.f, 0.f, 0.f, 0.f, 0.f, 0.f, 0.f, 0.f};
    f32x16 o[2] = {z16, z16}; float negm = tabc;
    float mref = 0.f, l = 0.f; bool fresh = true;
    const int nt = own * 4 + 4;
#define ROW_(i) ((i) * 64)
#define MBIT_(tt) (((tt) < own * 4) ? ((selb[wid * 32 + (fresh_lane() & 31)] >> ((tt) >> 2)) & 1u) != 0u : true)
#define TINFO_(tt, FAR, BIT) do { FAR = (tokw - ((tt) * 64 + 63) >= 128); BIT = MBIT_(tt); } while (0)
#define NEARFIX_(tt, P0, P1, BIT) do { const int l_ = fresh_lane(); bias_near<1, (1 << 30)>(P0, P1, tokw + (l_ & 31) - (tt) * 64, (const LAS float*)(lds + L_TABD) + (4 + hd) * 128, mref, BIT, l_ >> 5); } while (0)
    ATT_FUSE_LOOP(nt, Hb + LayB::KM + hd * 64, Hb + LayB::VM + hd * 64, HP)
#undef TINFO_
#undef NEARFIX_
#undef ROW_
#undef MBIT_
    {
        const int lane2 = fresh_lane(), r2 = lane2 & 31, h2 = lane2 >> 5;
        { const float lt = swapsum(l), inv = lt > 0.f ? 1.0f / lt : 0.f; scale_rows(o, inv, wsf, r2, h2); }
        { const RowOffTok ro{(size_t)tokw * DM + 256 + hd * 64}; store_cols(o, lds + L_OST + wid * 4096, MIXb, ro, lane2, r2, h2); } }
    __syncthreads();
}
#undef MX3_
}

template <class L>
__device__ __forceinline__ void cmp_unit(LAS unsigned char* lds, const bf16_t* __restrict__ H, const float* __restrict__ pe, const bf16_t* __restrict__ W1F, const float* __restrict__ b1,
                                         const float* __restrict__ w2, bf16_t* KCV, int unit, int wv) {
    typedef short bf16x8v __attribute__((ext_vector_type(8)));
    typedef float f32x16v __attribute__((ext_vector_type(16)));
    const int tid = fresh_tid_w(wv), lane = tid & 63, r32 = lane & 31, hi = lane >> 5, kh = wv >> 2, jg = wv & 3;
    const int which = unit >> 6, b = (unit >> 4) & 3, n0 = (unit & 15) * 32;
    LAS float* hid = (LAS float*)lds;
    LAS float* w2l = (LAS float*)(lds + 32768);
    {
        const f32x4_t* src = (const f32x4_t*)(w2 + (size_t)which * 256 * 64);
#pragma unroll
        for (int i = 0; i < 8; ++i) *(LAS f32x4_t*)(w2l + (tid + i * NTHR) * 4) = src[tid + i * NTHR];
    }
    const f32x16v z = {0.f, 0.f, 0.f, 0.f, 0.f, 0.f, 0.f, 0.f, 0.f, 0.f, 0.f, 0.f, 0.f, 0.f, 0.f, 0.f};
    f32x16v acc0 = z, acc1 = z;
    {
        const int n = n0 + r32 < NCMP ? n0 + r32 : NCMP - 1;
        const bf16_t* krow = H + (size_t)(b * S_ + n * 16) * L::P + L::KC + which * 64 + hi * 8;
        const float* pew = pe + which * 2048 + hi * 8;
        const bf16_t* wf = W1F + ((size_t)(which * 8 + 2 * jg) * 128) * 512 + lane * 8;
#pragma unroll 4
        for (int kk = 0; kk < 64; ++kk) {
            const int ks = kh * 64 + kk, p = ks >> 2, dc = ks & 3;
            const uint4 kraw = *(const uint4*)(krow + (size_t)p * L::P + dc * 16);
            const float4 pa = *(const float4*)(pew + ks * 16), pb = *(const float4*)(pew + ks * 16 + 4);
            const bf16x8v a0 = *(const bf16x8v*)(wf + (size_t)ks * 512), a1 = *(const bf16x8v*)(wf + (size_t)(128 + ks) * 512);
            typedef unsigned u32x4v __attribute__((ext_vector_type(4)));
            const u32x4v bw = {pk2(QLO(kraw.x) + pa.x, QHI(kraw.x) + pa.y), pk2(QLO(kraw.y) + pa.z, QHI(kraw.y) + pa.w), pk2(QLO(kraw.z) + pb.x, QHI(kraw.z) + pb.y), pk2(QLO(kraw.w) + pb.z, QHI(kraw.w) + pb.w)};
            const bf16x8v bf = __builtin_bit_cast(bf16x8v, bw);
            acc0 = __builtin_amdgcn_mfma_f32_32x32x16_bf16(a0, bf, acc0, 0, 0, 0);
            acc1 = __builtin_amdgcn_mfma_f32_32x32x16_bf16(a1, bf, acc1, 0, 0, 0);
        }
    }
    if (kh == 1) {
#pragma unroll
        for (int r = 0; r < 16; ++r) { const int jj = (r & 3) + 8 * (r >> 2) + 4 * hi; hid[(64 * jg + jj) * 32 + r32] = acc0[r]; hid[(64 * jg + 32 + jj) * 32 + r32] = acc1[r]; }
    }
    __syncthreads();
    if (kh == 0) {
#pragma unroll
        for (int r = 0; r < 16; ++r) { const int jj = (r & 3) + 8 * (r >> 2) + 4 * hi;
#pragma unroll
            for (int t = 0; t < 2; ++t) { const int j = 64 * jg + 32 * t + jj; const float a = (t == 0 ? acc0[r] : acc1[r]) + hid[j * 32 + r32] + b1[which * 256 + j];
                float u = 0.7978845608028654f * (a + 0.044715f * a * a * a); u = fminf(fmaxf(u, -15.f), 15.f);
                const float e = __builtin_amdgcn_exp2f(u * 2.885390081777927f), th = (e - 1.0f) / (e + 1.0f);
                hid[j * 32 + r32] = 0.5f * a * (1.0f + th); } }
    }
    __syncthreads();
    {
        const int d = tid & 63, ng = tid >> 6;
        float o[4] = {0.f, 0.f, 0.f, 0.f};
#pragma unroll 8
        for (int j = 0; j < 256; ++j) { const float wj = w2l[j * 64 + d]; const f32x4_t hv = *(const LAS f32x4_t*)(hid + j * 32 + ng * 4);
#pragma unroll
            for (int r = 0; r < 4; ++r) o[r] = fmaf(hv[r], wj, o[r]); }
#pragma unroll
        for (int r = 0; r < 4; ++r) { const int n = n0 + ng * 4 + r; KCV[(((size_t)which * B_ + b) * 512 + n) * 64 + d] = (bf16_t)f2bf(n < NCMP ? o[r] : 0.f); }
    }
    __syncthreads();
}
template <class L>
__device__ __forceinline__ void kmean_unit(LAS unsigned char* lds, const typename L::T* H, float* KM, int unit, int wave) {
    const int tid = fresh_tid_w(wave), b = unit >> 7, h = (unit >> 5) & 3, j = unit & 31, d = tid & 63, g = tid >> 6;
    LAS float* part = (LAS float*)lds;
    const typename L::T* src = H + (size_t)(b * S_ + j * 256) * L::P + L::KM + h * 64 + d;
    float s = 0.f;
    for (int r = g; r < 256; r += 8) s += ldf(src + (size_t)r * L::P);
    part[g * 64 + d] = s;
    __syncthreads();
    if (tid < 64) { float t = 0.f;
#pragma unroll
        for (int gg = 0; gg < 8; ++gg) t += part[gg * 64 + tid];
        KM[((size_t)(b * 4 + h) * 32 + j) * 64 + tid] = t * (1.0f / 256.0f); }
    __syncthreads();
}
template <class L>
__device__ __forceinline__ void conv_unit(LAS unsigned char* lds, const bf16_t* __restrict__ H, const float* __restrict__ wdw, const float* __restrict__ bdw, const float* __restrict__ lng,
                                          const float* __restrict__ lnb, const bf16_t* __restrict__ WPT, bf16_t* __restrict__ MIX, int unit, int wave) {
    typedef short bf16x8v __attribute__((ext_vector_type(8)));
    typedef float f32x16v __attribute__((ext_vector_type(16)));
    const int tid = fresh_tid_w(wave), g0 = unit * 64, tb = g0 & (S_ - 1);
    LAS bf16_t* HsB = (LAS bf16_t*)lds;
    LAS float* Ys = (LAS float*)(lds + 49152);
    LAS unsigned char* Ab = lds;
    for (int q = tid; q < 94 * 32; q += NTHR) {
        const int r = q >> 5, c8 = q & 31, dt = r - 30;
        typedef unsigned u32x4v __attribute__((ext_vector_type(4)));
        u32x4v o = {0u, 0u, 0u, 0u};
        if (tb + dt >= 0) {
            const bf16_t* hr = H + (size_t)(g0 + dt) * L::P + L::CV + c8 * 8;
            const uint4 a = *(const uint4*)hr, g = *(const uint4*)(hr + 256);
            const unsigned av[4] = {a.x, a.y, a.z, a.w}, gv[4] = {g.x, g.y, g.z, g.w}; unsigned ov[4];
#pragma unroll
            for (int i = 0; i < 4; ++i) ov[i] = pk2(QLO(av[i]) * sigmoidf_(QLO(gv[i])), QHI(av[i]) * sigmoidf_(QHI(gv[i])));
            o = (u32x4v){ov[0], ov[1], ov[2], ov[3]};
        }
        *(LAS u32x4v*)(HsB + r * 256 + c8 * 8) = o;
    }
    __syncthreads();
    {
        const int cp = tid & 127, tg = tid >> 7;
        float w0[31], w1[31];
#pragma unroll
        for (int k = 0; k < 31; ++k) { const float2 wv = *(const float2*)(wdw + k * 256 + 2 * cp); w0[k] = wv.x; w1[k] = wv.y; }
        const float2 bb = *(const float2*)(bdw + 2 * cp);
        float a0[16], a1[16];
#pragma unroll
        for (int i = 0; i < 16; ++i) { a0[i] = bb.x; a1[i] = bb.y; }
#pragma unroll
        for (int rr = 0; rr < 46; ++rr) {
            const unsigned hv = *(const LAS unsigned*)(HsB + (16 * tg + rr) * 256 + 2 * cp);
            const float h0 = QLO(hv), h1 = QHI(hv);
#pragma unroll
            for (int i = 0; i < 16; ++i) { const int k = rr - i; if (k >= 0 && k <= 30) { a0[i] = fmaf(h0, w0[k], a0[i]); a1[i] = fmaf(h1, w1[k], a1[i]); } }
        }
#pragma unroll
        for (int i = 0; i < 16; ++i) { typedef float f32x2v __attribute__((ext_vector_type(2))); *(LAS f32x2v*)(Ys + (16 * tg + i) * 256 + 2 * cp) = (f32x2v){a0[i], a1[i]}; }
    }
    __syncthreads();
    {
        const int wv = __builtin_amdgcn_readfirstlane(tid >> 6), lane = tid & 63;
        const f32x4_t gg = *(const f32x4_t*)(lng + 4 * lane), bt = *(const f32x4_t*)(lnb + 4 * lane);
#pragma unroll
        for (int i = 0; i < 8; ++i) {
            const int tk = wv * 8 + i;
            f32x4_t v = *(const LAS f32x4_t*)(Ys + tk * 256 + 4 * lane);
            float s = (v[0] + v[1]) + (v[2] + v[3]);
#pragma unroll
            for (int o = 1; o < 64; o <<= 1) s += __shfl_xor(s, o);
            const float mu = s * (1.0f / 256.0f);
            v = v - mu;
            float s2 = (v[0] * v[0] + v[1] * v[1]) + (v[2] * v[2] + v[3] * v[3]);
#pragma unroll
            for (int o = 1; o < 64; o <<= 1) s2 += __shfl_xor(s2, o);
            const float rstd = 1.0f / sqrtf(s2 * (1.0f / 256.0f) + 1e-5f);
            f32x4_t y = v * rstd * gg + bt;
#pragma unroll
            for (int e = 0; e < 4; ++e) y[e] = y[e] * sigmoidf_(y[e]);
            typedef unsigned u32x2v __attribute__((ext_vector_type(2)));
            *(LAS u32x2v*)(Ab + tk * 512 + (((lane >> 1) ^ (tk & 31)) * 16) + (lane & 1) * 8) = (u32x2v){pk2(y[0], y[1]), pk2(y[2], y[3])};
        }
    }
    __syncthreads();
    {
        const int wv = __builtin_amdgcn_readfirstlane(tid >> 6), lane = tid & 63, r32 = lane & 31, hi = lane >> 5, n0 = wv * 32;
        bf16x8v af[16];
#pragma unroll
        for (int ks = 0; ks < 16; ++ks) af[ks] = *(const bf16x8v*)(WPT + (size_t)(n0 + r32) * 256 + ks * 16 + hi * 8);
        const f32x16v z = {0.f, 0.f, 0.f, 0.f, 0.f, 0.f, 0.f, 0.f, 0.f, 0.f, 0.f, 0.f, 0.f, 0.f, 0.f, 0.f};
        f32x16v c0 = z, c1 = z;
#pragma unroll
        for (int ks = 0; ks < 16; ++ks) {
            const int ph = ((2 * ks + hi) ^ r32) * 16;
            const bf16x8v b0 = *(const LAS bf16x8v*)(Ab + r32 * 512 + ph), b1 = *(const LAS bf16x8v*)(Ab + (32 + r32) * 512 + ph);
            c0 = __builtin_amdgcn_mfma_f32_32x32x16_bf16(af[ks], b0, c0, 0, 0, 0);
            c1 = __builtin_amdgcn_mfma_f32_32x32x16_bf16(af[ks], b1, c1, 0, 0, 0);
        }
        typedef unsigned u32x2v __attribute__((ext_vector_type(2)));
#pragma unroll
        for (int g = 0; g < 4; ++g) {
            bf16_t* d0 = MIX + (size_t)(g0 + r32) * DM + 512 + n0 + 8 * g + 4 * hi;
            *(u32x2v*)d0 = (u32x2v){pk2(c0[4 * g], c0[4 * g + 1]), pk2(c0[4 * g + 2], c0[4 * g + 3])};
            *(u32x2v*)(d0 + (size_t)32 * DM) = (u32x2v){pk2(c1[4 * g], c1[4 * g + 1]), pk2(c1[4 * g + 2], c1[4 * g + 3])};
        }
    }
    __syncthreads();
}
template <class L>
__device__ __forceinline__ void hgrn1_unit(LAS unsigned char* lds, const bf16_t* __restrict__ H, const float* __restrict__ lb, float* __restrict__ OL, float* __restrict__ QP, float* __restrict__ U, float* __restrict__ Dg, int unit, int wave) {
    const int tid = fresh_tid_w(wave), v = tid & 63, kg = tid >> 6, k0 = kg * 8, b = unit >> 6, h = (unit >> 4) & 3, seg = unit & 15;
    LAS float* Fl = (LAS float*)lds; LAS float* Ql = Fl + HT * 64; LAS float* Vl = Ql + HT * 64; LAS float* QPl = Vl + HT * 64; LAS float* Op = QPl + HT * 64;
    static_assert(HT == 32, "piece mapping below assumes 32-token chunks");
    const int c8 = tid & 7, prow = (tid & 255) >> 3, parr = tid >> 8;
    const size_t colA = (parr == 0 ? L::FH : L::QH) + h * 64 + c8 * 8, colB = L::IH + h * 64 + c8 * 8;
    float lb8[8];
#pragma unroll
    for (int e = 0; e < 8; ++e) lb8[e] = lb[h * 64 + c8 * 8 + e];
    const size_t tb0 = (size_t)b * S_ + seg * HSEG;
    uint4 ra = *(const uint4*)(H + (tb0 + prow) * L::P + colA), rb = make_uint4(0u, 0u, 0u, 0u);
    if (tid < 256) rb = *(const uint4*)(H + (tb0 + prow) * L::P + colB);
    float s[8];
#pragma unroll
    for (int i = 0; i < 8; ++i) s[i] = 0.f;
    float P = 1.0f;
    for (int c = 0; c < HSEG / HT; ++c) {
        const size_t tb = tb0 + c * HT;
        {
            const unsigned wa[4] = {ra.x, ra.y, ra.z, ra.w};
            float va[8];
#pragma unroll
            for (int i = 0; i < 4; ++i) { va[2 * i] = QLO(wa[i]); va[2 * i + 1] = QHI(wa[i]); }
            if (parr == 0) {
#pragma unroll
                for (int e = 0; e < 8; ++e) va[e] = lb8[e] + (1.0f - lb8[e]) * sigmoidf_(va[e]);
            }
            LAS float* dst = (parr == 0 ? Fl : Ql) + prow * 64 + c8 * 8;
            *(LAS f32x4_t*)dst = (f32x4_t){va[0], va[1], va[2], va[3]}; *(LAS f32x4_t*)(dst + 4) = (f32x4_t){va[4], va[5], va[6], va[7]};
            if (tid < 256) { const unsigned wb[4] = {rb.x, rb.y, rb.z, rb.w}; LAS float* dv = Vl + prow * 64 + c8 * 8;
                *(LAS f32x4_t*)dv = (f32x4_t){QLO(wb[0]), QHI(wb[0]), QLO(wb[1]), QHI(wb[1])}; *(LAS f32x4_t*)(dv + 4) = (f32x4_t){QLO(wb[2]), QHI(wb[2]), QLO(wb[3]), QHI(wb[3])}; }
        }
        __syncthreads();
        if (c + 1 < HSEG / HT) {
            ra = *(const uint4*)(H + (tb + HT + prow) * L::P + colA);
            if (tid < 256) rb = *(const uint4*)(H + (tb + HT + prow) * L::P + colB);
        }
        for (int tt = 0; tt < HT; ++tt) {
            if (v < 8) { P *= Fl[tt * 64 + k0 + v]; QPl[tt * 64 + k0 + v] = Ql[tt * 64 + k0 + v] * P; }
            const float vv = Vl[tt * 64 + v];
            const f32x4_t fa = *(const LAS f32x4_t*)&Fl[tt * 64 + k0], fb = *(const LAS f32x4_t*)&Fl[tt * 64 + k0 + 4];
            const f32x4_t qa = *(const LAS f32x4_t*)&Ql[tt * 64 + k0], qb = *(const LAS f32x4_t*)&Ql[tt * 64 + k0 + 4];
            const float f[8] = {fa.x, fa.y, fa.z, fa.w, fb.x, fb.y, fb.z, fb.w}, q[8] = {qa.x, qa.y, qa.z, qa.w, qb.x, qb.y, qb.z, qb.w};
            float o0 = 0.f, o1 = 0.f;
#pragma unroll
            for (int i = 0; i < 8; i += 2) {
                s[i] = fmaf(f[i], s[i], (1.0f - f[i]) * vv); o0 = fmaf(q[i], s[i], o0);
                s[i + 1] = fmaf(f[i + 1], s[i + 1], (1.0f - f[i + 1]) * vv); o1 = fmaf(q[i + 1], s[i + 1], o1);
            }
            Op[(kg * HT + tt) * 64 + v] = o0 + o1;
        }
        __syncthreads();
        for (int idx = tid; idx < HT * 64; idx += NTHR) {
            const int tt = idx >> 6, cc = idx & 63;
            float o = 0.f;
#pragma unroll
            for (int g = 0; g < 8; ++g) o += Op[(g * HT + tt) * 64 + cc];
            OL[(tb + tt) * 256 + h * 64 + cc] = o;
            QP[(tb + tt) * 256 + h * 64 + cc] = QPl[idx];
        }
        __syncthreads();
    }
    float* Uu = U + (size_t)unit * 4096;
#pragma unroll
    for (int i = 0; i < 8; ++i) Uu[(k0 + i) * 64 + v] = s[i];
    if (v < 8) Dg[unit * 64 + k0 + v] = P;
}
template <class L>
__device__ __forceinline__ void hgrn2_unit(const bf16_t* __restrict__ H, const float* __restrict__ OL, const float* __restrict__ QP, const float* __restrict__ U, const float* __restrict__ Dg,
                                           const float* __restrict__ ng, bf16_t* __restrict__ MIX, int unit, int wv) {
    const int tid = fresh_tid_w(wv), v = tid & 63, b = unit >> 6, h = (unit >> 4) & 3, seg = unit & 15;
    float Sr[64];
#pragma unroll
    for (int k = 0; k < 64; ++k) Sr[k] = 0.f;
    for (int j = 0; j < seg; ++j) {
        const float* Uu = U + (size_t)(unit - seg + j) * 4096; const float dv = Dg[(unit - seg + j) * 64 + v];
#pragma unroll
        for (int k = 0; k < 64; ++k) Sr[k] = fmaf(__uint_as_float(__builtin_amdgcn_readlane(__float_as_uint(dv), k)), Sr[k], Uu[k * 64 + v]);
    }
    const float gn = ng[h * 64 + v];
    const size_t t0 = (size_t)b * S_ + seg * HSEG + wv * 64;
    for (int i0 = 0; i0 < 64; i0 += 8) {
        float ol[8], qp[8], gg[8];
#pragma unroll
        for (int i = 0; i < 8; ++i) { const size_t t = t0 + i0 + i; ol[i] = OL[t * 256 + h * 64 + v]; qp[i] = QP[t * 256 + h * 64 + v]; gg[i] = bf2f(H[t * L::P + L::GH + h * 64 + v]); }
#pragma unroll
        for (int i = 0; i < 8; ++i) {
            float o0 = ol[i], o1 = 0.f;
#pragma unroll
            for (int k = 0; k < 64; k += 2) { o0 = fmaf(__uint_as_float(__builtin_amdgcn_readlane(__float_as_uint(qp[i]), k)), Sr[k], o0); o1 = fmaf(__uint_as_float(__builtin_amdgcn_readlane(__float_as_uint(qp[i]), k + 1)), Sr[k + 1], o1); }
            const float o = o0 + o1;
            float ss = o * o;
#pragma unroll
            for (int d = 1; d < 64; d <<= 1) ss += __shfl_xor(ss, d);
            const float r = 1.0f / sqrtf(ss * (1.0f / 64.0f) + 1e-6f);
            MIX[(t0 + i0 + i) * DM + 768 + h * 64 + v] = (bf16_t)f2bf(o * r * gn * sigmoidf_(gg[i]));
        }
    }
}

struct Frame {
    LAS unsigned char* lds; volatile LAS unsigned* MISC; unsigned* ctl;
    int tid, lane, wave, vcu, G;
};
template <bool FRAG>
__device__ __forceinline__ void transpose_item(const float* __restrict__ W, int K, int N, bf16_t* WT, LAS float* scr, int item, int lane, int shift_at, int shift) {
    const int nblk = (N + 31) / 32, kb = item / nblk, nb = item % nblk, k0 = 64 * kb, n0 = 32 * nb;
    const int nl = n0 + (lane & 31);
#pragma unroll 8
    for (int i = 0; i < 32; ++i) { const int kk = 2 * i + (lane >> 5); scr[kk * 33 + (lane & 31)] = nl < N ? W[(size_t)(k0 + kk) * N + nl] : 0.f; }
    asm volatile("s_waitcnt lgkmcnt(0)" ::: "memory");
    const int c = lane & 7;
#pragma unroll
    for (int j = 0; j < 4; ++j) { const int n = (lane >> 3) + 8 * j; const LAS float* s = scr + (8 * c) * 33 + n; const int ng = n0 + n;
        if (ng < N) { uint4 o; o.x = pk2(s[0 * 33], s[1 * 33]); o.y = pk2(s[2 * 33], s[3 * 33]); o.z = pk2(s[4 * 33], s[5 * 33]); o.w = pk2(s[6 * 33], s[7 * 33]);
            const int kq = k0 + 8 * c;
            if (FRAG) *(uint4*)(WT + ((((size_t)(ng >> 5) * (K >> 4) + (kq >> 4)) * 64 + ((kq >> 3) & 1) * 32 + (ng & 31)) * 8)) = o;
            else *(uint4*)(WT + (size_t)(ng + (ng >= shift_at ? shift : 0)) * K + kq) = o; } }
    asm volatile("s_waitcnt lgkmcnt(0)" ::: "memory");
}
__device__ __forceinline__ void ln_row(const float* xrow, const float* __restrict__ g, const float* __restrict__ bta, float* orow, bf16_t* brow, int lane) {
    typedef float f32x4 __attribute__((ext_vector_type(4)));
    const f32x4* xr = (const f32x4*)xrow + lane;
    f32x4 v[4]; float s = 0.f;
#pragma unroll
    for (int j = 0; j < 4; ++j) { v[j] = xr[64 * j]; s += (v[j].x + v[j].y) + (v[j].z + v[j].w); }
#pragma unroll
    for (int o = 1; o < 64; o <<= 1) s += __shfl_xor(s, o);
    const float mean = s * (1.f / DM); float s2 = 0.f;
#pragma unroll
    for (int j = 0; j < 4; ++j) { v[j] = v[j] - mean; s2 += (v[j].x * v[j].x + v[j].y * v[j].y) + (v[j].z * v[j].z + v[j].w * v[j].w); }
#pragma unroll
    for (int o = 1; o < 64; o <<= 1) s2 += __shfl_xor(s2, o);
    const float rstd = 1.f / sqrtf(s2 * (1.f / DM) + 1e-5f);
#pragma unroll
    for (int j = 0; j < 4; ++j) { const f32x4 gg = ((const f32x4*)g)[lane + 64 * j], bb = ((const f32x4*)bta)[lane + 64 * j];
        const f32x4 y = v[j] * rstd * gg + bb;
        ((f32x4*)orow)[lane + 64 * j] = y;
        ((unsigned long long*)brow)[lane + 64 * j] = (unsigned long long)pk2(y.x, y.y) | ((unsigned long long)pk2(y.z, y.w) << 32); }
}

struct Args { const float* in[21]; float* out; unsigned char* ws; int ph_lo, ph_hi; };
constexpr int NPHASE = 1 + 8 * DEPTH;

__global__ void __launch_bounds__(NTHR, 2) mega_fwd(Args args) {
    extern __shared__ __attribute__((aligned(16))) unsigned char lds_raw[];
    Frame F;
    F.lds = (LAS unsigned char*)lds_raw;
    F.MISC = (volatile LAS unsigned*)(F.lds + MISC_OFF);
    F.tid = threadIdx.x; F.lane = F.tid & 63; F.wave = __builtin_amdgcn_readfirstlane(F.tid >> 6);
    F.G = gridDim.x; { const int bx = blockIdx.x; F.vcu = (F.G % 8 == 0) ? (bx % 8) * (F.G / 8) + bx / 8 : bx; }
    unsigned char* ws = args.ws;
    F.ctl = (unsigned*)(ws + WS_CTL);
#define WS_PTRS() const __attribute__((address_space(4))) Args* ap_ = (const __attribute__((address_space(4))) Args*)__builtin_amdgcn_kernarg_segment_ptr(); asm volatile("" : "+s"(ap_)); \
    int vcu_ = F.vcu, G_ = F.G, bx_ = (int)blockIdx.x, wave_ = F.wave; asm volatile("" : "+s"(vcu_), "+s"(G_), "+s"(bx_), "+s"(wave_)); (void)vcu_; (void)G_; (void)bx_; (void)wave_; \
    const float* x = ap_->in[0]; const float* w_in = ap_->in[1]; const float* cmp_pe = ap_->in[2]; const float* cmp_w1 = ap_->in[3]; const float* cmp_b1 = ap_->in[4]; const float* cmp_w2 = ap_->in[5]; \
    const float* dw_w = ap_->in[6]; const float* dw_b = ap_->in[7]; const float* cln_g = ap_->in[8]; const float* cln_b = ap_->in[9]; const float* pw_w = ap_->in[10]; const float* lb_logits = ap_->in[11]; \
    const float* hn_g = ap_->in[12]; const float* w_out = ap_->in[13]; const float* ln1_g = ap_->in[14]; const float* ln1_b = ap_->in[15]; const float* w_ff1 = ap_->in[16]; const float* w_ff2 = ap_->in[17]; \
    const float* ln2_g = ap_->in[18]; const float* ln2_b = ap_->in[19]; const float* rel = ap_->in[20]; float* out = ap_->out; unsigned char* wsl = ap_->ws; \
    (void)x; (void)w_in; (void)cmp_pe; (void)cmp_w1; (void)cmp_b1; (void)cmp_w2; (void)dw_w; (void)dw_b; (void)cln_g; (void)cln_b; (void)pw_w; (void)lb_logits; (void)hn_g; (void)w_out; \
    (void)ln1_g; (void)ln1_b; (void)w_ff1; (void)w_ff2; (void)ln2_g; (void)ln2_b; (void)rel; (void)out; \
    bf16_t* WIN = (bf16_t*)(wsl + WS_WIN); bf16_t* WOUT = (bf16_t*)(wsl + WS_WOUT); bf16_t* W1 = (bf16_t*)(wsl + WS_W1); bf16_t* W2 = (bf16_t*)(wsl + WS_W2); \
    bf16_t* XB = (bf16_t*)(wsl + WS_XB); bf16_t* HB = (bf16_t*)(wsl + WS_H); bf16_t* MIX = (bf16_t*)(wsl + WS_MIX); bf16_t* HFF = (bf16_t*)(wsl + WS_HFF); \
    bf16_t* KCV = (bf16_t*)(wsl + WS_KCV); float* KM = (float*)(wsl + WS_KM); float* OL = (float*)(wsl + WS_OL); float* QP = (float*)(wsl + WS_QP); \
    float* U = (float*)(wsl + WS_U); float* Dg = (float*)(wsl + WS_DG); float* LBS = (float*)(wsl + WS_LBS); bf16_t* WPT = (bf16_t*)(wsl + WS_WPT); bf16_t* W1CT = (bf16_t*)(wsl + WS_W1CT); \
    (void)WIN; (void)WOUT; (void)W1; (void)W2; (void)XB; (void)HB; (void)MIX; (void)HFF; (void)KCV; (void)KM; (void)OL; (void)QP; (void)U; (void)Dg; (void)LBS; (void)WPT; (void)W1CT;
    for (int u = F.tid; u < (LDS_BYTES - LDSCTL_OFF) / 4; u += NTHR) ((LAS unsigned*)(F.lds + LDSCTL_OFF))[u] = 0u;
    __syncthreads();
    XcdBarrier bar = xcd_barrier_post((unsigned*)(F.ctl + CW_BAR), F.MISC + 8);
    const int lo = args.ph_lo, hi = args.ph_hi;
#define IN(k) (lo <= (k) && (k) < hi)
#define SEAM(k) do { if (IN(k) && IN((k) + 1)) xcd_barrier(bar); } while (0)

    if (IN(0)) { WS_PTRS();
#ifdef REP_PRO
        for (int rep_ = 0; rep_ < 2; ++rep_) {
#endif
        const int wave = wave_, tid = fresh_tid_w(wave), lane = tid & 63;
        LAS float* scr = (LAS float*)(F.lds + wave * 16384);
        const int gw = vcu_ * NWAVES + wave, NGW = G_ * NWAVES;
        constexpr int I_IN = 16 * 93, I_OUT = 16 * 32, I_1 = 16 * 128, I_2 = 64 * 32, I_PW = 4 * 8, I_C1 = 2 * 256;
        constexpr int NITEMS = DEPTH * (I_IN + I_OUT + I_1 + I_2 + I_PW + I_C1);
        for (int it = gw; it < NITEMS; it += NGW) {
            int r = it; const int l = r / (I_IN + I_OUT + I_1 + I_2 + I_PW + I_C1); r -= l * (I_IN + I_OUT + I_1 + I_2 + I_PW + I_C1);
            if (r < I_IN) { transpose_item<false>(w_in + (size_t)l * DM * INC, DM, INC, WIN + (size_t)l * HP * DM, scr, r, lane, SHIFT_AT, SHIFT); continue; } r -= I_IN;
            if (r < I_OUT) { transpose_item<false>(w_out + (size_t)l * DM * DM, DM, DM, WOUT + (size_t)l * DM * DM, scr, r, lane, 1 << 30, 0); continue; } r -= I_OUT;
            if (r < I_1) { transpose_item<false>(w_ff1 + (size_t)l * DM * FF, DM, FF, W1 + (size_t)l * FF * DM, scr, r, lane, 1 << 30, 0); continue; } r -= I_1;
            if (r < I_2) { transpose_item<false>(w_ff2 + (size_t)l * FF * DM, FF, DM, W2 + (size_t)l * DM * FF, scr, r, lane, 1 << 30, 0); continue; } r -= I_2;
            if (r < I_PW) { transpose_item<false>(pw_w + (size_t)l * 65536, 256, 256, WPT + (size_t)l * 65536, scr, r, lane, 1 << 30, 0); continue; } r -= I_PW;
            { const int wh = r >> 8; transpose_item<true>(cmp_w1 + ((size_t)l * 2 + wh) * 2048 * 256, 2048, 256, W1CT + ((size_t)l * 2 + wh) * 256 * 2048, scr, r & 255, lane, 1 << 30, 0); }
        }
        for (int i = gw * 64 + lane; i < DEPTH * 116 * 128; i += NGW * 64) {
            const int l = i / (116 * 128), r = (i / 128) % 116, c = i % 128;
            *(uint4*)(WIN + ((size_t)l * HP + 652 + r) * DM + c * 8) = make_uint4(0u, 0u, 0u, 0u);
        }
        for (size_t i = (size_t)gw * 64 + lane; i < (size_t)MTOK * DM / 8; i += (size_t)NGW * 64) {
            const float4 a = ((const float4*)x)[2 * i], b = ((const float4*)x)[2 * i + 1];
            uint4 o; o.x = pk2(a.x, a.y); o.y = pk2(a.z, a.w); o.z = pk2(b.x, b.y); o.w = pk2(b.z, b.w);
            ((uint4*)XB)[i] = o;
        }
        if (bx_ == 0 && tid < 256) {
            const int i = tid; const float a0 = lb_logits[i], a1 = lb_logits[256 + i], mx = fmaxf(a0, a1);
            const float e0 = expf(a0 - mx), e1 = expf(a1 - mx), p0 = e0 / (e0 + e1), p1 = e1 / (e0 + e1);
            LBS[i] = p0 - p0; LBS[256 + i] = (p0 + p1) - p0;
        }
#ifdef REP_PRO
        }
#endif
    }
    SEAM(0);

#ifdef UNROLL_L
#pragma unroll
#endif
    for (int l = 0; l < DEPTH; ++l) {
        const int pb = 1 + 8 * l;
        if (IN(pb + 0)) { WS_PTRS();
            pg8::Gemm g{XB, WIN + (size_t)l * HP * DM, MTOK, HP, DM}; pg8::StaticOrder S; S.init(MTOK, HP, G_, bx_);
            pg8::EpiBf16<0> E{HB, HP, 0x9u, 0.125f * 1.4426950408889634f};
            pg8::gemm_phase<pg8::EpiBf16<0>, pg8::StaticOrder, true, true>(F.lds, g, S, E, wave_);
#ifdef REP_INPROJ
            __syncthreads(); pg8::gemm_phase<pg8::EpiBf16<0>, pg8::StaticOrder, true, true>(F.lds, g, S, E, wave_);
#endif
        }
        SEAM(pb + 0);
        if (IN(pb + 1)) { WS_PTRS();
            constexpr int N_H1 = B_ * 4 * NSEG, N_CMP = 128, N_KM = B_ * 4 * 32, N_CV = MTOK / 64;
#ifdef REP_P2A
            for (int rep_ = 0; rep_ < 2; ++rep_)
#endif
            for (int u = vcu_; u < N_H1 + N_CMP + N_KM + N_CV; u += G_) {
                int r = u;
                #ifndef SKIP_H1
                if (r < N_H1) { hgrn1_unit<LayB>(F.lds, HB, LBS + l * 256, OL, QP, U, Dg, r, wave_);
#ifdef REP_H1
                    __syncthreads(); hgrn1_unit<LayB>(F.lds, HB, LBS + l * 256, OL, QP, U, Dg, r, wave_);
#endif
                    continue; }
#endif
                r -= N_H1;
#ifndef SKIP_CMP
                if (r < N_CMP) { cmp_unit<LayB>(F.lds, HB, cmp_pe + (size_t)l * 2 * 2048, W1CT + (size_t)l * 2 * 256 * 2048, cmp_b1 + (size_t)l * 2 * 256, cmp_w2 + (size_t)l * 2 * 256 * 64, KCV, r, wave_);
#ifdef REP_CMP
                    cmp_unit<LayB>(F.lds, HB, cmp_pe + (size_t)l * 2 * 2048, W1CT + (size_t)l * 2 * 256 * 2048, cmp_b1 + (size_t)l * 2 * 256, cmp_w2 + (size_t)l * 2 * 256 * 64, KCV, r, wave_);
#endif
                    continue; }
#endif
                r -= N_CMP;
#ifndef SKIP_KM
                if (r < N_KM) { kmean_unit<LayB>(F.lds, HB, KM, r, wave_);
#ifdef REP_KM
                    kmean_unit<LayB>(F.lds, HB, KM, r, wave_);
#endif
                    continue; }
#endif
                r -= N_KM;
#ifndef SKIP_CONV
                conv_unit<LayB>(F.lds, HB, dw_w + (size_t)l * 31 * 256, dw_b + l * 256, cln_g + l * 256, cln_b + l * 256, WPT + (size_t)l * 65536, MIX, r, wave_);
#ifdef REP_CONV
                conv_unit<LayB>(F.lds, HB, dw_w + (size_t)l * 31 * 256, dw_b + l * 256, cln_g + l * 256, cln_b + l * 256, WPT + (size_t)l * 65536, MIX, r, wave_);
#endif
#endif
            }
        }
        SEAM(pb + 1);
        if (IN(pb + 2)) {
            { WS_PTRS(); att::build_tabd(F.lds, rel, fresh_tid_w(wave_)); }
            int vcu_ = F.vcu, G_ = F.G; asm volatile("" : "+s"(vcu_), "+s"(G_));
#ifndef SKIP_NSA
            for (int u = vcu_; u < 256; u += G_) {
                WS_PTRS(); const int b = u >> 6, i = u & 63; const bf16_t* Hb = HB + (size_t)b * S_ * HP; bf16_t* Mb = MIX + (size_t)b * S_ * DM;
                const bf16_t* KCb = KCV + (size_t)(0 * B_ + b) * 512 * 64; const bf16_t* VCb = KCV + (size_t)(1 * B_ + b) * 512 * 64;
                att::nsa_block(F.lds, Hb, KCb, VCb, Mb, 127 - i, wave_);
                att::nsa_block(F.lds, Hb, KCb, VCb, Mb, i, wave_);
#ifdef REP_NSA
                att::nsa_block(F.lds, Hb, KCb, VCb, Mb, 127 - i, wave_);
                att::nsa_block(F.lds, Hb, KCb, VCb, Mb, i, wave_);
#endif
            }
#endif
#ifndef SKIP_MOBA
            for (int u = vcu_; u < 256; u += G_) {
                WS_PTRS(); const int b = u >> 6, hd = (u >> 4) & 3, k = u & 15; const bf16_t* Hb = HB + (size_t)b * S_ * HP; bf16_t* Mb = MIX + (size_t)b * S_ * DM;
                const float* KMh = KM + (size_t)(b * 4 + hd) * 32 * 64;
                att::moba_block(F.lds, Hb, KMh, Mb, hd, 31 - k, wave_);
                att::moba_block(F.lds, Hb, KMh, Mb, hd, k, wave_);
#ifdef REP_MOBA
                att::moba_block(F.lds, Hb, KMh, Mb, hd, 31 - k, wave_);
                att::moba_block(F.lds, Hb, KMh, Mb, hd, k, wave_);
#endif
            }
#endif
#ifndef SKIP_H2
            for (int u = vcu_; u < 256; u += G_) {
                WS_PTRS(); hgrn2_unit<LayB>(HB, OL, QP, U, Dg, hn_g + l * 256, MIX, u, wave_);
#ifdef REP_H2
                hgrn2_unit<LayB>(HB, OL, QP, U, Dg, hn_g + l * 256, MIX, u, wave_);
#endif
            }
#endif
        }
        SEAM(pb + 2);
        if (IN(pb + 3)) { WS_PTRS();
            pg8::Gemm g{MIX, WOUT + (size_t)l * DM * DM, MTOK, DM, DM}; pg8::StaticOrder S; S.init(MTOK, DM, G_, bx_);
            pg8::EpiResF32 E{(l == 0) ? x : out, out, DM, ALPHA};
            pg8::gemm_phase<pg8::EpiResF32, pg8::StaticOrder, true, true>(F.lds, g, S, E, wave_);
        }
        SEAM(pb + 3);
        if (IN(pb + 4)) { WS_PTRS();
            const int wave = wave_, tid = fresh_tid_w(wave), lane = tid & 63;
            const int gw = vcu_ * NWAVES + wave, NGW = G_ * NWAVES;
#ifdef REP_LN
            for (int m = gw; m < MTOK; m += NGW) ln_row(out + (size_t)m * DM, ln1_g + l * DM, ln1_b + l * DM, (float*)HFF + (size_t)m * DM, XB + (size_t)m * DM, lane);
#endif
            for (int m = gw; m < MTOK; m += NGW) ln_row(out + (size_t)m * DM, ln1_g + l * DM, ln1_b + l * DM, out + (size_t)m * DM, XB + (size_t)m * DM, lane);
        }
        SEAM(pb + 4);
        if (IN(pb + 5)) { WS_PTRS();
            pg8::Gemm g{XB, W1 + (size_t)l * FF * DM, MTOK, FF, DM}; pg8::StaticOrder S; S.init(MTOK, FF, G_, bx_);
            pg8::EpiBf16<2> E{HFF, FF, 0u, 1.0f};
            pg8::gemm_phase<pg8::EpiBf16<2>, pg8::StaticOrder, true, true>(F.lds, g, S, E, wave_);
#ifdef REP_FF1
            __syncthreads(); pg8::gemm_phase<pg8::EpiBf16<2>, pg8::StaticOrder, true, true>(F.lds, g, S, E, wave_);
#endif
        }
        SEAM(pb + 5);
        if (IN(pb + 6)) { WS_PTRS();
            pg8::Gemm g{HFF, W2 + (size_t)l * DM * FF, MTOK, DM, FF}; pg8::StaticOrder S; S.init(MTOK, DM, G_, bx_);
            pg8::EpiResF32 E{out, out, DM, ALPHA};
            pg8::gemm_phase<pg8::EpiResF32, pg8::StaticOrder, true, true>(F.lds, g, S, E, wave_);
        }
        SEAM(pb + 6);
        if (IN(pb + 7)) { WS_PTRS();
            const int wave = wave_, tid = fresh_tid_w(wave), lane = tid & 63;
            const int gw = vcu_ * NWAVES + wave, NGW = G_ * NWAVES;
#ifdef REP_LN
            for (int m = gw; m < MTOK; m += NGW) ln_row(out + (size_t)m * DM, ln2_g + l * DM, ln2_b + l * DM, (float*)HFF + (size_t)m * DM, XB + (size_t)m * DM, lane);
#endif
            for (int m = gw; m < MTOK; m += NGW) ln_row(out + (size_t)m * DM, ln2_g + l * DM, ln2_b + l * DM, out + (size_t)m * DM, XB + (size_t)m * DM, lane);
        }
        SEAM(pb + 7);
    }
#undef IN
#undef SEAM
}

#ifndef MK_PER_PHASE
#define MK_PER_PHASE 0
#endif
extern "C" void kernel_launch(void* const* d_in, const int* in_sizes, int n_in, void* d_out, int out_size, void* d_ws, size_t ws_size, hipStream_t stream) {
    static int grid = 0;
    if (grid == 0) {
        if (n_in != 21 || out_size != MTOK * DM || ws_size < WS_END) { fprintf(stderr, "kernel_launch: unexpected problem (n_in %d out %d ws %zu)\n", n_in, out_size, ws_size); grid = -1; return; }
        int dev = 0, cus = 0, per_cu = 0;
        if (hipGetDevice(&dev) != hipSuccess || hipDeviceGetAttribute(&cus, hipDeviceAttributeMultiprocessorCount, dev) != hipSuccess) { grid = -1; return; }
        if (hipFuncSetAttribute((const void*)mega_fwd, hipFuncAttributeMaxDynamicSharedMemorySize, LDS_BYTES) != hipSuccess) { fprintf(stderr, "kernel_launch: hipFuncSetAttribute failed\n"); grid = -1; return; }
        if (hipOccupancyMaxActiveBlocksPerMultiprocessor(&per_cu, (const void*)mega_fwd, NTHR, LDS_BYTES) != hipSuccess || per_cu < 1) { fprintf(stderr, "kernel_launch: occupancy query says %d\n", per_cu); }
        (void)hipGetLastError();
        grid = cus;
    }
    if (grid < 0) return;
    (void)hipMemsetAsync((char*)d_ws + WS_CTL, 0, CTL_ZERO_BYTES, stream);
    Args a{};
    for (int i = 0; i < 21; ++i) a.in[i] = (const float*)d_in[i];
    a.out = (float*)d_out; a.ws = (unsigned char*)d_ws;
#if MK_PER_PHASE
    for (int p = 0; p < NPHASE; ++p) { a.ph_lo = p; a.ph_hi = p + 1; hipLaunchKernelGGL(mega_fwd, dim3(grid), dim3(NTHR), LDS_BYTES, stream, a); }
#else
    a.ph_lo = 0; a.ph_hi = NPHASE;
    hipLaunchKernelGGL(mega_fwd, dim3(grid), dim3(NTHR), LDS_BYTES, stream, a);
#endif
}
```
